# Optimizing an MI355X kernel written in HIP

```python
import math
import jax, jax.numpy as jnp
from jax import lax
import numpy as np

D_MODEL = 2048
BATCH = 32
SEQ = 256
DEPTH = 4
DEC_BATCH = 8
DEC_SEQ = 2048
PAST_LEN = 512

GRID_W = 64
HEAD_DIM = 64
RWKV_W = 3 * D_MODEL // 8
RWKV_HEADS = RWKV_W // HEAD_DIM
HYENA_W = D_MODEL // 4
ATTN_W = 3 * D_MODEL // 8
ATTN_HEADS = ATTN_W // HEAD_DIM
ATTN_KV_HEADS = ATTN_HEADS // 3
GQA_GROUP = ATTN_HEADS // ATTN_KV_HEADS
KV_W = ATTN_KV_HEADS * HEAD_DIM
DECAY_LORA = 64
A_LORA = 64
GN_EPS = 64e-5
HYENA_ORDER = 2
HYENA_SHORT = 3
FILTER_EMB = 33
FILTER_HID = 64
HY_MIN_DECAY = math.log(1e-2) / 1.5
HY_MAX_DECAY = math.log(1e-2) / 0.3
WINDOW = 128
BLOCK = 128
ROPE_BASE = 10000.0
D_FF = 5504
FFN_CONV = 3
LN_EPS = 1e-5
DN_ALPHA = (2 * DEPTH) ** 0.25
DN_BETA = (8 * DEPTH) ** -0.25
IN_WIDTHS = (RWKV_W, RWKV_W, RWKV_W, RWKV_W, (HYENA_ORDER + 1) * HYENA_W, ATTN_W, KV_W, KV_W)
IN_W = sum(IN_WIDTHS)
IN_SPLITS = tuple(int(s) for s in np.cumsum(IN_WIDTHS)[:-1])

kernel_name = 'hybrid_rwkv_hyena_swa_diffusion_step'

F32 = jnp.float32


def layer_norm(x, g, b):
    xf = x.astype(F32)
    mu = jnp.mean(xf, -1, keepdims=True)
    var = jnp.mean(jnp.square(xf - mu), -1, keepdims=True)
    return ((xf - mu) * lax.rsqrt(var + LN_EPS)).astype(x.dtype) * g + b


def dwconv_centred(u, w):
    K = w.shape[0]
    pad = K // 2
    T = u.shape[1]
    up = jnp.pad(u, ((0, 0), (pad, pad), (0, 0)))
    return sum(up[:, j:j + T] * w[j] for j in range(K))


def rwkv_scan(r, decay, k, v, kk, a, init, reverse):
    def step(S, inp):
        r_t, w_t, k_t, v_t, kk_t, a_t = inp
        sa = jnp.einsum('bhvk,bhk->bhv', S, -kk_t)
        S = (S * w_t[:, :, None, :] + sa[..., None] * (kk_t * a_t)[:, :, None, :]
             + v_t[..., None] * k_t[:, :, None, :])
        return S, jnp.einsum('bhvk,bhk->bhv', S, r_t)
    xs = tuple(jnp.swapaxes(t, 0, 1) for t in (r, decay, k, v, kk, a))
    S, o = lax.scan(step, init.astype(F32), xs, reverse=reverse)
    return jnp.swapaxes(o, 0, 1), S


def rwkv_mixer(h, r, k, v, g, init, w0, w1, w2, a0, a1, a2, k_k, k_a, r_k, lnx_g, lnx_b):
    B, T, _ = h.shape
    heads = lambda t: t.reshape(B, T, RWKV_HEADS, HEAD_DIM).astype(F32)
    kk = heads(k * k_k)
    kk = kk / jnp.maximum(jnp.sqrt(jnp.sum(kk * kk, -1, keepdims=True)), 1e-12)
    rh, vh, kh = heads(r), heads(v), heads(k)
    k_a_h = k_a.reshape(RWKV_HEADS, HEAD_DIM).astype(F32)
    out = 0.0
    bonus = 0.0
    finals = []
    for d in range(2):
        w = -jax.nn.softplus(-(w0[d] + jnp.tanh(h @ w1[d]) @ w2[d])) - 0.5
        decay = jnp.exp(-jnp.exp(heads(w)))
        a = heads(jax.nn.sigmoid(a0[d] + (h @ a1[d]) @ a2[d]))
        kd = kh * (1.0 + (a - 1.0) * k_a_h)
        o, S = rwkv_scan(rh, decay, kd, vh, kk, a, init[d], reverse=(d == 1))
        out = out + o
        bonus = bonus + jnp.sum(rh * kd * r_k.astype(F32), -1, keepdims=True) * vh
        finals.append(S)
    mu = jnp.mean(out, -1, keepdims=True)
    var = jnp.mean(jnp.square(out - mu), -1, keepdims=True)
    on = ((out - mu) * lax.rsqrt(var + GN_EPS)).reshape(B, T, RWKV_W) * lnx_g + lnx_b
    y = (on + bonus.reshape(B, T, RWKV_W)) * jax.nn.sigmoid(g.astype(F32))
    return y.astype(h.dtype), jnp.stack(finals, 0)


def hyena_filters(L, f_w1, f_b1, f_freq1, f_w2, f_b2, f_freq2, f_w3):
    t = jnp.linspace(0.0, 1.0, L, dtype=F32)[:, None]
    bands = (FILTER_EMB - 1) // 2
    t_res = jnp.arange(L, dtype=F32)[:, None]
    f = jnp.linspace(1e-4, bands - 1, bands, dtype=F32)[None, :]
    ang = 2.0 * math.pi * t_res * f / L
    z = jnp.concatenate([t, jnp.cos(ang), jnp.sin(ang)], -1)
    hm = jnp.sin(f_freq1 * (z @ f_w1 + f_b1))
    hm = jnp.sin(f_freq2 * (hm @ f_w2 + f_b2))
    hf = (hm @ f_w3).astype(F32).reshape(L, HYENA_ORDER, 2, HYENA_W)
    deltas = jnp.abs(jnp.linspace(HY_MIN_DECAY, HY_MAX_DECAY, HYENA_W, dtype=F32))
    hf = hf * jnp.exp(-t * deltas)[:, None, None, :]
    causal = hf[:, :, 0]
    anti = hf[1:, :, 1][::-1]
    zero = jnp.zeros((1, HYENA_ORDER, HYENA_W), F32)
    return jnp.concatenate([causal, zero, anti], 0)


def fft_conv(u, kern, bias):
    L = u.shape[1]
    uf = jnp.fft.rfft(u.astype(F32), n=2 * L, axis=1)
    kf = jnp.fft.rfft(kern, n=2 * L, axis=0)
    y = jnp.fft.irfft(uf * kf[None], n=2 * L, axis=1)[:, :L]
    return (y + u.astype(F32) * bias).astype(u.dtype)


def hyena_mixer(u, short_w, f_w1, f_b1, f_freq1, f_w2, f_b2, f_freq2, f_w3, hy_bias):
    L = u.shape[1]
    u = dwconv_centred(u, short_w)
    streams = jnp.split(u, HYENA_ORDER + 1, axis=-1)
    kern = hyena_filters(L, f_w1, f_b1, f_freq1, f_w2, f_b2, f_freq2, f_w3)
    z = streams[0]
    for n in range(HYENA_ORDER):
        z = streams[n + 1] * fft_conv(z, kern[:, n], hy_bias[n])
    return z


def axial_rope(T):
    rows = T // GRID_W
    row = jnp.repeat(jnp.arange(rows), GRID_W).astype(F32)
    col = jnp.tile(jnp.arange(GRID_W), rows).astype(F32)
    nf = HEAD_DIM // 4
    inv = ROPE_BASE ** (-jnp.arange(nf, dtype=F32) / nf)
    ang = jnp.concatenate([row[:, None] * inv, col[:, None] * inv], -1)
    return jnp.cos(ang), jnp.sin(ang)


def apply_rope(x, cos, sin):
    half = HEAD_DIM // 2
    x1 = x[..., :half].astype(F32)
    x2 = x[..., half:].astype(F32)
    c = cos[None, :, None, :]
    s = sin[None, :, None, :]
    return jnp.concatenate([x1 * c - x2 * s, x1 * s + x2 * c], -1).astype(x.dtype)


def sink_softmax_av(s, v, sink):
    snk = sink.astype(F32).reshape(1, ATTN_KV_HEADS, GQA_GROUP, 1, 1)
    m = jnp.maximum(jnp.max(s, -1, keepdims=True), snk)
    p = jnp.exp(s - m)
    p = p / (jnp.sum(p, -1, keepdims=True) + jnp.exp(snk - m))
    return jnp.einsum('bhgqk,bkhd->bqhgd', p.astype(v.dtype), v)


def context_attention(q, k, v, sink):
    B, S = q.shape[:2]
    nb = S // BLOCK
    qb = jnp.swapaxes(q.reshape(B, nb, BLOCK, ATTN_KV_HEADS, GQA_GROUP, HEAD_DIM), 0, 1)
    scale = HEAD_DIM ** -0.5
    def block(qblk):
        s = jnp.einsum('bqhgd,bkhd->bhgqk', qblk, k).astype(F32) * scale
        return sink_softmax_av(s, v, sink)
    o = lax.map(block, qb)
    return jnp.swapaxes(o, 0, 1).reshape(B, S, ATTN_W)


def latent_attention(q, k, v, ctx_k, ctx_v, sink):
    B, T = q.shape[:2]
    nb = T // BLOCK
    qg = q.reshape(B, T, ATTN_KV_HEADS, GQA_GROUP, HEAD_DIM)
    kp = jnp.pad(k, ((0, 0), (BLOCK, BLOCK), (0, 0), (0, 0)))
    vp = jnp.pad(v, ((0, 0), (BLOCK, BLOCK), (0, 0), (0, 0)))
    ctx_k = ctx_k.astype(q.dtype)
    ctx_v = ctx_v.astype(v.dtype)
    scale = HEAD_DIM ** -0.5
    def block(i):
        start = i * BLOCK
        qb = lax.dynamic_slice_in_dim(qg, start, BLOCK, axis=1)
        kb = lax.dynamic_slice_in_dim(kp, start, 3 * BLOCK, axis=1)
        vb = lax.dynamic_slice_in_dim(vp, start, 3 * BLOCK, axis=1)
        qpos = start + jnp.arange(BLOCK)
        kpos = start - BLOCK + jnp.arange(3 * BLOCK)
        ok = ((jnp.abs(qpos[:, None] - kpos[None, :]) <= WINDOW)
              & (kpos >= 0)[None, :] & (kpos < T)[None, :])
        s_loc = jnp.where(ok, jnp.einsum('bqhgd,bkhd->bhgqk', qb, kb).astype(F32) * scale, -jnp.inf)
        s_ctx = jnp.einsum('bqhgd,bkhd->bhgqk', qb, ctx_k).astype(F32) * scale
        return sink_softmax_av(jnp.concatenate([s_loc, s_ctx], -1),
                               jnp.concatenate([vb, ctx_v], 1), sink)
    o = lax.map(block, jnp.arange(nb))
    return jnp.swapaxes(o, 0, 1).reshape(B, T, ATTN_W)


def conv_ffn(h, w_up, conv_w, w_down):
    u = dwconv_centred(h @ w_up, conv_w)
    a, b = jnp.split(u, 2, axis=-1)
    return (jax.nn.silu(a) * b) @ w_down


def trunk_layer(x, cond, p, rwkv_init, ctx_k=None, ctx_v=None):
    B, T, _ = x.shape
    mod = (jax.nn.silu(cond) @ p['w_mod'] + p['b_mod'])[:, None, :]
    shift1, scale1, gate1, shift2, scale2, gate2 = jnp.split(mod, 6, axis=-1)
    h = x * (1.0 + scale1) + shift1
    proj = h @ p['w_in']
    r, k, v, g, hy_u, q, ak, av = jnp.split(proj, IN_SPLITS, axis=-1)
    o_a, S = rwkv_mixer(h, r, k, v, g, rwkv_init, p['rwkv_w0'], p['rwkv_w1'], p['rwkv_w2'],
                        p['rwkv_a0'], p['rwkv_a1'], p['rwkv_a2'], p['rwkv_k_k'], p['rwkv_k_a'],
                        p['rwkv_r_k'], p['rwkv_lnx_g'], p['rwkv_lnx_b'])
    o_b = hyena_mixer(hy_u, p['hy_short_w'], p['hy_f_w1'], p['hy_f_b1'], p['hy_f_freq1'],
                      p['hy_f_w2'], p['hy_f_b2'], p['hy_f_freq2'], p['hy_f_w3'], p['hy_bias'])
    q = q.reshape(B, T, ATTN_HEADS, HEAD_DIM)
    ak = ak.reshape(B, T, ATTN_KV_HEADS, HEAD_DIM)
    av = av.reshape(B, T, ATTN_KV_HEADS, HEAD_DIM)
    if ctx_k is None:
        o_c = context_attention(q, ak, av, p['attn_sink'])
        ctx_out = (S, ak, av)
    else:
        cos, sin = axial_rope(T)
        o_c = latent_attention(apply_rope(q, cos, sin), apply_rope(ak, cos, sin), av,
                               ctx_k, ctx_v, p['attn_sink'])
        ctx_out = None
    mix = jnp.concatenate([o_a.astype(x.dtype), o_b.astype(x.dtype), o_c.astype(x.dtype)], -1) @ p['w_out']
    x = layer_norm(DN_ALPHA * x + gate1 * mix, p['ln1_g'], p['ln1_b'])
    h2 = x * (1.0 + scale2) + shift2
    f = conv_ffn(h2, p['ffn_w_up'], p['ffn_conv_w'], p['ffn_w_down'])
    x = layer_norm(DN_ALPHA * x + gate2 * f, p['ln2_g'], p['ln2_b'])
    return x, ctx_out


def setup_inputs(seed: int = 0) -> dict:
    key = jax.random.key(seed)
    ks = iter(jax.random.split(key, 64))
    def nrm(shape, s):
        return s * jax.random.normal(next(ks), shape, F32)
    L = DEPTH
    D = D_MODEL
    return {
        'x_prompt': nrm((BATCH, SEQ, D), 1.0),
        'x_sample': nrm((DEC_BATCH, DEC_SEQ, D), 1.0),
        'c': nrm((DEC_BATCH, D), 1.0),
        'state_rwkv': nrm((DEC_BATCH, DEPTH, 2, RWKV_HEADS, HEAD_DIM, HEAD_DIM), 0.5),
        'cache_k': nrm((DEC_BATCH, DEPTH, PAST_LEN, ATTN_KV_HEADS, HEAD_DIM), 1.0),
        'cache_v': nrm((DEC_BATCH, DEPTH, PAST_LEN, ATTN_KV_HEADS, HEAD_DIM), 1.0),
        'c_ctx': nrm((D,), 1.0),
        'w_mod': nrm((L, D, 6 * D), 0.5 * D ** -0.5),
        'b_mod': nrm((L, 6 * D), 0.02),
        'w_in': nrm((L, D, IN_W), D ** -0.5),
        'rwkv_w0': jax.random.uniform(next(ks), (L, 2, RWKV_W), F32, -6.0, -1.0),
        'rwkv_w1': nrm((L, 2, D, DECAY_LORA), D ** -0.5),
        'rwkv_w2': nrm((L, 2, DECAY_LORA, RWKV_W), 0.1 * DECAY_LORA ** -0.5),
        'rwkv_a0': nrm((L, 2, RWKV_W), 0.1),
        'rwkv_a1': nrm((L, 2, D, A_LORA), D ** -0.5),
        'rwkv_a2': nrm((L, 2, A_LORA, RWKV_W), 0.1 * A_LORA ** -0.5),
        'rwkv_k_k': 0.85 + nrm((L, RWKV_W), 0.02),
        'rwkv_k_a': 1.0 + nrm((L, RWKV_W), 0.02),
        'rwkv_r_k': nrm((L, RWKV_HEADS, HEAD_DIM), 0.1),
        'rwkv_lnx_g': 1.0 + nrm((L, RWKV_W), 0.02),
        'rwkv_lnx_b': nrm((L, RWKV_W), 0.02),
        'hy_short_w': nrm((L, HYENA_SHORT, (HYENA_ORDER + 1) * HYENA_W), HYENA_SHORT ** -0.5),
        'hy_f_w1': nrm((L, FILTER_EMB, FILTER_HID), FILTER_EMB ** -0.5),
        'hy_f_b1': nrm((L, FILTER_HID), 0.1),
        'hy_f_freq1': 1.0 + nrm((L, FILTER_HID), 0.02),
        'hy_f_w2': nrm((L, FILTER_HID, FILTER_HID), FILTER_HID ** -0.5),
        'hy_f_b2': nrm((L, FILTER_HID), 0.1),
        'hy_f_freq2': 1.0 + nrm((L, FILTER_HID), 0.02),
        'hy_f_w3': nrm((L, FILTER_HID, HYENA_ORDER * 2 * HYENA_W), 0.05 * FILTER_HID ** -0.5),
        'hy_bias': nrm((L, HYENA_ORDER, HYENA_W), 0.5),
        'attn_sink': nrm((L, ATTN_HEADS), 0.5),
        'w_out': nrm((L, D, D), DN_BETA * D ** -0.5),
        'ln1_g': 1.0 + nrm((L, D), 0.02),
        'ln1_b': nrm((L, D), 0.02),
        'ffn_w_up': nrm((L, D, 2 * D_FF), D ** -0.5),
        'ffn_conv_w': nrm((L, FFN_CONV, 2 * D_FF), FFN_CONV ** -0.5),
        'ffn_w_down': nrm((L, D_FF, D), DN_BETA * D_FF ** -0.5),
        'ln2_g': 1.0 + nrm((L, D), 0.02),
        'ln2_b': nrm((L, D), 0.02),
    }


def reference(x_prompt, x_sample, c, state_rwkv, cache_k, cache_v, c_ctx,
              w_mod, b_mod, w_in,
              rwkv_w0, rwkv_w1, rwkv_w2, rwkv_a0, rwkv_a1, rwkv_a2,
              rwkv_k_k, rwkv_k_a, rwkv_r_k, rwkv_lnx_g, rwkv_lnx_b,
              hy_short_w, hy_f_w1, hy_f_b1, hy_f_freq1, hy_f_w2, hy_f_b2, hy_f_freq2, hy_f_w3, hy_bias,
              attn_sink, w_out, ln1_g, ln1_b, ffn_w_up, ffn_conv_w, ffn_w_down, ln2_g, ln2_b):
    params = dict(w_mod=w_mod, b_mod=b_mod, w_in=w_in,
                  rwkv_w0=rwkv_w0, rwkv_w1=rwkv_w1, rwkv_w2=rwkv_w2,
                  rwkv_a0=rwkv_a0, rwkv_a1=rwkv_a1, rwkv_a2=rwkv_a2,
                  rwkv_k_k=rwkv_k_k, rwkv_k_a=rwkv_k_a, rwkv_r_k=rwkv_r_k,
                  rwkv_lnx_g=rwkv_lnx_g, rwkv_lnx_b=rwkv_lnx_b,
                  hy_short_w=hy_short_w, hy_f_w1=hy_f_w1, hy_f_b1=hy_f_b1, hy_f_freq1=hy_f_freq1,
                  hy_f_w2=hy_f_w2, hy_f_b2=hy_f_b2, hy_f_freq2=hy_f_freq2, hy_f_w3=hy_f_w3,
                  hy_bias=hy_bias, attn_sink=attn_sink, w_out=w_out, ln1_g=ln1_g, ln1_b=ln1_b,
                  ffn_w_up=ffn_w_up, ffn_conv_w=ffn_conv_w, ffn_w_down=ffn_w_down,
                  ln2_g=ln2_g, ln2_b=ln2_b)

    xc = x_prompt
    Bp = x_prompt.shape[0]
    zero_state = jnp.zeros((2, Bp, RWKV_HEADS, HEAD_DIM, HEAD_DIM), F32)
    states, keys, vals = [], [], []
    for l in range(DEPTH):
        p = {n: a[l] for n, a in params.items()}
        xc, (S, kc, vc) = trunk_layer(xc, c_ctx[None, :], p, zero_state)
        states.append(jnp.moveaxis(S, 0, 1))
        keys.append(kc)
        vals.append(vc)
    y_prompt = xc
    new_state_rwkv = jnp.stack(states, 1)
    new_cache_k = jnp.stack(keys, 1)
    new_cache_v = jnp.stack(vals, 1)

    xs = x_sample
    for l in range(DEPTH):
        p = {n: a[l] for n, a in params.items()}
        init = jnp.moveaxis(state_rwkv[:, l], 1, 0)
        xs, _ = trunk_layer(xs, c, p, init, cache_k[:, l], cache_v[:, l])
    y_sample = xs

    return (y_prompt, y_sample, new_state_rwkv, new_cache_k, new_cache_v)
```

```cpp
#include <hip/hip_runtime.h>
#include <cstdio>
#include <cstdint>

#ifndef DBG_SKIP_RWKV
#define DBG_SKIP_RWKV 0
#endif
#ifndef DBG_SKIP_HYENA
#define DBG_SKIP_HYENA 0
#endif
#ifndef DBG_SKIP_ATTN
#define DBG_SKIP_ATTN 0
#endif
#ifndef DBG_SKIP_FFN
#define DBG_SKIP_FFN 0
#endif

#ifndef REP_GEMM
#define REP_GEMM 1
#endif
#ifndef REP_SCAN
#define REP_SCAN 1
#endif
#ifndef REP_HY
#define REP_HY 1
#endif
#ifndef REP_ATT
#define REP_ATT 1
#endif
#ifndef REP_FIN
#define REP_FIN 1
#endif
#ifndef REP_CG
#define REP_CG 1
#endif
#ifndef REP_P0
#define REP_P0 1
#endif
#define LAS __attribute__((address_space(3)))
typedef unsigned short bf16;
typedef short bf16x8 __attribute__((ext_vector_type(8)));
typedef short s16x4 __attribute__((ext_vector_type(4)));
typedef float f32x4 __attribute__((ext_vector_type(4)));
typedef float f32x2 __attribute__((ext_vector_type(2)));
typedef float f32x16 __attribute__((ext_vector_type(16)));
typedef unsigned u32x4 __attribute__((ext_vector_type(4)));
typedef unsigned u32x2 __attribute__((ext_vector_type(2)));
typedef __bf16 hwbf16x2 __attribute__((ext_vector_type(2)));

constexpr int D = 2048, NB_C = 32, T_C = 256, NB_D = 8, T_D = 2048, DEPTH = 4, PAST = 512;
constexpr int MC = NB_C * T_C, MD = NB_D * T_D, M = MC + MD;
constexpr int RW = 768, RH = 12, HD = 64, HW = 512, AW = 768, AH = 12, KVH = 4, KVW = 256;
constexpr int INW = 5888, N1 = 6144, DFF = 5504, NUP = 11008, NMOD = 12288;
constexpr int NQKV = 1280;
constexpr float LN_EPS = 1e-5f, GN_EPS = 64e-5f;
constexpr float DN_ALPHA = 1.681792830507429f;
enum { I_XP = 0, I_XS, I_C, I_STATE, I_CK, I_CV, I_CCTX, I_WMOD, I_BMOD, I_WIN, I_W0, I_W1, I_W2, I_A0, I_A1, I_A2, I_KK, I_KA, I_RK, I_LNXG, I_LNXB,
       I_HSW, I_FW1, I_FB1, I_FF1, I_FW2, I_FB2, I_FF2, I_FW3, I_HBIAS, I_SINK, I_WOUT, I_LN1G, I_LN1B, I_WUP, I_CONVW, I_WDN, I_LN2G, I_LN2B, N_IN };
constexpr size_t O_Y = 0, O_STATE = (size_t)M * D, O_CK = O_STATE + (size_t)NB_C * DEPTH * 2 * RH * 64 * 64, O_CV = O_CK + (size_t)NB_C * DEPTH * T_C * KVW;

constexpr size_t MiB = 1u << 20;
constexpr size_t WS_CTL = 0;
constexpr size_t WS_MOD = 1 * MiB;
constexpr size_t WS_ROPE = 3 * MiB;
constexpr size_t WS_FILT = 4 * MiB;
constexpr size_t FILT_LAYER = 9 * MiB, FILT_CTX_OFF = 8 * MiB;
constexpr size_t WS_WIN = 40 * MiB;
constexpr size_t WS_WOUT = WS_WIN + 96 * MiB;
constexpr size_t WS_WUP = WS_WOUT + 32 * MiB;
constexpr size_t WS_WDN = WS_WUP + 172 * MiB;
constexpr size_t WS_WL2 = WS_WDN + 86 * MiB;
constexpr size_t WS_X1 = WS_WL2 + 6 * MiB;
constexpr size_t WS_H = WS_X1 + 192 * MiB;
constexpr size_t WS_BIG = WS_H + 96 * MiB;
constexpr size_t WS_U = WS_BIG;
constexpr size_t WS_G = WS_BIG + 516 * MiB;
constexpr size_t WS_RKVG = WS_BIG;
constexpr size_t WS_QKV = WS_BIG + 144 * MiB;
constexpr size_t WS_LH = WS_BIG + 204 * MiB;
constexpr size_t WS_HYT = WS_BIG + 216 * MiB;
constexpr size_t WS_LW = WS_BIG + 288 * MiB;
constexpr size_t WS_MIX = WS_BIG + 432 * MiB;
constexpr size_t WS_OF = WS_BIG + 528 * MiB;
constexpr size_t WS_OB = WS_BIG + 600 * MiB;
constexpr size_t WS_HYO = WS_BIG + 672 * MiB;
constexpr size_t WS_BS = WS_BIG + 696 * MiB;
constexpr size_t WS_INV = WS_BIG + 700 * MiB;
constexpr size_t WS_HALO = WS_BIG + 774 * MiB;
constexpr size_t WS_END = WS_HALO + 18 * MiB;
static_assert(WS_END <= 1536 * MiB, "workspace");

constexpr int CW_BAR = 4096;
constexpr int CW_Q = 16384;

constexpr int LDS_BYTES = 147456;
constexpr int LDS_MISC = 147456 - 256;

__device__ __forceinline__ unsigned f2bf(float f) { unsigned u = __float_as_uint(f); return (u + 0x7fffu + ((u >> 16) & 1u)) >> 16; }
__device__ __forceinline__ float bf2f(unsigned b) { return __uint_as_float(b << 16); }
__device__ __forceinline__ unsigned pk2(float lo, float hi) { hwbf16x2 b = __builtin_convertvector((f32x2){lo, hi}, hwbf16x2); return __builtin_bit_cast(unsigned, b); }
__device__ __forceinline__ float bflo(unsigned w) { return __uint_as_float(w << 16); }
__device__ __forceinline__ float bfhi(unsigned w) { return __uint_as_float(w & 0xffff0000u); }
__device__ __forceinline__ float sigmoidf_(float x) { return 1.0f / (1.0f + __expf(-x)); }
__device__ __forceinline__ float siluf_(float x) { return x / (1.0f + __expf(-x)); }
#define VM_WAIT() asm volatile("s_waitcnt vmcnt(0)" ::: "memory")

namespace pg8 {
#define PG8_LAS __attribute__((address_space(3)))
typedef unsigned short bf16_t;
typedef short bf16x8 __attribute__((ext_vector_type(8)));
typedef float f32x4 __attribute__((ext_vector_type(4)));
typedef unsigned u32x4 __attribute__((ext_vector_type(4)));
constexpr int BM = 256, BK = 64, HALF = 128, HTB = HALF * BK * 2  , STAGE_BYTES = 8 * HTB, NXCD = 8, WGM = 8;

__host__ __device__ __forceinline__ int lds_byte(int r, int c) { const int st = (r >> 4) * 2 + (c >> 5), rr = r & 15, cc = c & 31, ob = rr * 64 + cc * 2; return st * 1024 + (ob ^ (((ob >> 9) & 1) << 5)); }
__host__ __device__ __forceinline__ void stage_rc(int b, int& R, int& C) { const int st = b / 1024, sb = b % 1024, swz = sb ^ (((sb >> 9) & 1) << 5); R = (st >> 1) * 16 + swz / 64; C = (st & 1) * 32 + (swz % 64) / 2; }
__host__ __device__ __forceinline__ int perm32(int rho) { const int n = rho >> 4, i = rho & 15; return 8 * (i >> 2) + 4 * n + (i & 3); }

struct Unit { int pm, pn; };
struct Gemm { const bf16_t* A; const bf16_t* Bt; int M, N, K; };

struct StaticOrder {
    int nM, nN, nwg, G, c;
    __host__ __device__ void init(int M, int N, int G_, int c_) { nM = M / BM; nN = N / BM; nwg = nM * nN; G = G_; c = c_; }
    __host__ __device__ bool next(int i, Unit& u) const {
        const long L = (long)i * G + c; if (L >= nwg) return false;
        int wgid = (int)L; { const int q = nwg / NXCD, r = nwg % NXCD, xcd = wgid % NXCD, off = wgid / NXCD; wgid = (xcd < r ? xcd * (q + 1) : r * (q + 1) + (xcd - r) * q) + off; }
        const int nig = WGM * nN, gid = wgid / nig, fm = gid * WGM, gsz = (nM - fm) < WGM ? (nM - fm) : WGM;
        u.pm = fm + ((wgid % nig) % gsz); u.pn = (wgid % nig) / gsz; return true;
    }
    __device__ __forceinline__ void a_ready(const Unit&) const {}
    __device__ __forceinline__ void done(const Unit&) const {}
};

__device__ __forceinline__ unsigned cvt_pk_bf16(float lo, float hi) { unsigned r; asm volatile("v_cvt_pk_bf16_f32 %0, %1, %2" : "=v"(r) : "v"(lo), "v"(hi)); return r; }

struct EpiPlain {
    static constexpr bool PERM = true, AFTER_DRAIN = false;
    bf16_t* O; int ldc;
    __device__ __forceinline__ void operator()(const f32x4 (&acc)[2][2][4][2], const Unit& u, int wr, int wc, int fr, int fq) const {
        const int row0 = u.pm * BM + wr * 64 + fr, col0 = u.pn * BM + wc * 32 + 8 * fq;
#pragma unroll
        for (int ai = 0; ai < 2; ++ai)
#pragma unroll
            for (int m = 0; m < 4; ++m) { bf16_t* rowp = O + (size_t)(row0 + ai * HALF + m * 16) * ldc + col0;
#pragma unroll
                for (int bj = 0; bj < 2; ++bj) { const f32x4 v0 = acc[ai][bj][m][0], v1 = acc[ai][bj][m][1];
                    u32x4 w; w.x = cvt_pk_bf16(v0[0], v0[1]); w.y = cvt_pk_bf16(v0[2], v0[3]); w.z = cvt_pk_bf16(v1[0], v1[1]); w.w = cvt_pk_bf16(v1[2], v1[3]);
                    *(u32x4*)(rowp + bj * HALF) = w; } }
    }
};

struct Epi1 {
    static constexpr bool PERM = true, AFTER_DRAIN = false;
    bf16_t* rkvg; bf16_t* qkv; bf16_t* lh; bf16_t* hyt; float* ck; float* cv; int layer; int Mrows;
    __device__ __forceinline__ void operator()(const f32x4 (&acc)[2][2][4][2], const Unit& u, int wr, int wc, int fr, int fq) const {
        const int row0 = u.pm * BM + wr * 64 + fr, cw = wc * 32 + 8 * fq, pn = u.pn;
        if (pn >= 12 && pn < 18) {
            const int c0 = (pn - 12) * BM + cw;
#pragma unroll
            for (int ai = 0; ai < 2; ++ai)
#pragma unroll
                for (int m = 0; m < 4; ++m) { const int row = row0 + ai * HALF + m * 16;
#pragma unroll
                    for (int bj = 0; bj < 2; ++bj)
#pragma unroll
                        for (int n = 0; n < 2; ++n)
#pragma unroll
                            for (int e = 0; e < 4; ++e) {
                                const unsigned w = cvt_pk_bf16(acc[ai][bj][m][n][e], 0.f);
                                hyt[(size_t)(c0 + bj * HALF + 4 * n + e) * Mrows + row] = (bf16_t)w; } }
            return;
        }
        bf16_t* base; int ldc; int coff; bool th = false; float* fdst = nullptr;
        if (pn < 12) { base = rkvg; ldc = 3072; coff = pn * BM; }
        else if (pn < 21) { base = qkv; ldc = 1280; coff = (pn - 18) * BM; }
        else if (pn == 21) { base = qkv; ldc = 1280; coff = 768; fdst = ck; }
        else if (pn == 22) { base = qkv; ldc = 1280; coff = 1024; fdst = cv; }
        else { base = lh; ldc = 256; coff = 0; th = true; }
        if (u.pm >= 32) fdst = nullptr;
#pragma unroll
        for (int ai = 0; ai < 2; ++ai)
#pragma unroll
            for (int m = 0; m < 4; ++m) { const int row = row0 + ai * HALF + m * 16; bf16_t* rowp = base + (size_t)row * ldc + coff + cw;
#pragma unroll
                for (int bj = 0; bj < 2; ++bj) { f32x4 v0 = acc[ai][bj][m][0], v1 = acc[ai][bj][m][1];
                    if (th && bj == 0) {
#pragma unroll
                        for (int e = 0; e < 4; ++e) { v0[e] = tanhf(v0[e]); v1[e] = tanhf(v1[e]); } }
                    u32x4 w; w.x = cvt_pk_bf16(v0[0], v0[1]); w.y = cvt_pk_bf16(v0[2], v0[3]); w.z = cvt_pk_bf16(v1[0], v1[1]); w.w = cvt_pk_bf16(v1[2], v1[3]);
                    *(u32x4*)(rowp + bj * HALF) = w;
                    if (fdst) { float* fp = fdst + ((size_t)(u.pm * 4 + layer) * 256 + (row & 255)) * 256 + cw + bj * HALF; *(f32x4*)fp = v0; *(f32x4*)(fp + 4) = v1; } } }
    }
};


struct EpiGate {
    static constexpr bool PERM = true, AFTER_DRAIN = false;
    bf16_t* G; const float* cw; float* halo; PG8_LAS unsigned char* edge;
    template <int CTRL> static __device__ __forceinline__ float dpp(float x) { return __int_as_float(__builtin_amdgcn_update_dpp(0, __float_as_int(x), CTRL, 0xf, 0xf, false)); }
    __device__ __forceinline__ void operator()(const f32x4 (&acc)[2][2][4][2], const Unit& u, int wr, int wc, int fr, int fq) const {
        const int cw0 = wc * 32 + 8 * fq, j0 = u.pn * 128 + cw0;
        PG8_LAS float* E = (PG8_LAS float*)edge;
#pragma unroll
        for (int ai = 0; ai < 2; ++ai) { const int g4 = 2 * ai + wr;
            if (fr == 0) {
#pragma unroll
                for (int bj = 0; bj < 2; ++bj)
#pragma unroll
                    for (int n = 0; n < 2; ++n) *(PG8_LAS f32x4*)(E + (g4 * 2 + 0) * 256 + bj * HALF + cw0 + 4 * n) = acc[ai][bj][0][n]; }
            if (fr == 15) {
#pragma unroll
                for (int bj = 0; bj < 2; ++bj)
#pragma unroll
                    for (int n = 0; n < 2; ++n) *(PG8_LAS f32x4*)(E + (g4 * 2 + 1) * 256 + bj * HALF + cw0 + 4 * n) = acc[ai][bj][3][n]; }
        }
        if (wr == 0 && fr < 2) { float* hp = halo + ((size_t)u.pm * 4 + fr) * 11008 + j0;
#pragma unroll
            for (int n = 0; n < 2; ++n) { *(f32x4*)(hp + 4 * n) = acc[0][0][0][n]; *(f32x4*)(hp + 5504 + 4 * n) = acc[0][1][0][n]; } }
        if (wr == 1 && fr >= 14) { float* hp = halo + ((size_t)u.pm * 4 + 2 + (fr - 14)) * 11008 + j0;
#pragma unroll
            for (int n = 0; n < 2; ++n) { *(f32x4*)(hp + 4 * n) = acc[1][0][3][n]; *(f32x4*)(hp + 5504 + 4 * n) = acc[1][1][3][n]; } }
        asm volatile("s_waitcnt lgkmcnt(0)" ::: "memory"); __builtin_amdgcn_s_barrier(); asm volatile("" ::: "memory");
        const int row0 = u.pm * BM + wr * 64 + fr;
#pragma unroll
        for (int ai = 0; ai < 2; ++ai) { const int g4 = 2 * ai + wr;
#pragma unroll
            for (int n = 0; n < 2; ++n) {
                f32x4 ca[4];
                { f32x4 w[3];
#pragma unroll
                  for (int tp = 0; tp < 3; ++tp) w[tp] = *(const f32x4*)(cw + tp * 11008 + j0 + 4 * n);
                  f32x4 pe = (f32x4){0.f, 0.f, 0.f, 0.f}, ne = pe;
                  if (g4 > 0) pe = *(const PG8_LAS f32x4*)(E + ((g4 - 1) * 2 + 1) * 256 + cw0 + 4 * n);
                  if (g4 < 3) ne = *(const PG8_LAS f32x4*)(E + ((g4 + 1) * 2 + 0) * 256 + cw0 + 4 * n);
#pragma unroll
                  for (int m = 0; m < 4; ++m) { const f32x4 v = acc[ai][0][m][n], vp = (m > 0) ? acc[ai][0][m - 1][n] : pe, vn = (m < 3) ? acc[ai][0][m + 1][n] : ne;
#pragma unroll
                      for (int e = 0; e < 4; ++e) { const float prev = dpp<0x121>((fr == 15) ? vp[e] : v[e]), next = dpp<0x12F>((fr == 0) ? vn[e] : v[e]); ca[m][e] = w[0][e] * prev + w[1][e] * v[e] + w[2][e] * next; } } }
                { f32x4 w[3];
#pragma unroll
                  for (int tp = 0; tp < 3; ++tp) w[tp] = *(const f32x4*)(cw + tp * 11008 + 5504 + j0 + 4 * n);
                  f32x4 pe = (f32x4){0.f, 0.f, 0.f, 0.f}, ne = pe;
                  if (g4 > 0) pe = *(const PG8_LAS f32x4*)(E + ((g4 - 1) * 2 + 1) * 256 + HALF + cw0 + 4 * n);
                  if (g4 < 3) ne = *(const PG8_LAS f32x4*)(E + ((g4 + 1) * 2 + 0) * 256 + HALF + cw0 + 4 * n);
#pragma unroll
                  for (int m = 0; m < 4; ++m) { const f32x4 v = acc[ai][1][m][n], vp = (m > 0) ? acc[ai][1][m - 1][n] : pe, vn = (m < 3) ? acc[ai][1][m + 1][n] : ne; float o[4];
#pragma unroll
                      for (int e = 0; e < 4; ++e) { const float prev = dpp<0x121>((fr == 15) ? vp[e] : v[e]), next = dpp<0x12F>((fr == 0) ? vn[e] : v[e]); const float cb = w[0][e] * prev + w[1][e] * v[e] + w[2][e] * next;
                          const float a = ca[m][e]; o[e] = a * __builtin_amdgcn_rcpf(1.0f + __expf(-a)) * cb; }
                      u32x2 wv; wv.x = cvt_pk_bf16(o[0], o[1]); wv.y = cvt_pk_bf16(o[2], o[3]);
                      *(u32x2*)(G + (size_t)(row0 + ai * HALF + m * 16) * 5504 + j0 + 4 * n) = wv; } }
            }
        }
    }
};

struct EpiRes {
    static constexpr bool PERM = false, AFTER_DRAIN = false;
    const float* xa; const float* xb; int nrows_a; const float* gate;   int gstride; float* dst; int ldc; float alpha;
    __device__ __forceinline__ void operator()(const f32x4 (&acc)[2][2][4][2], const Unit& u, int wr, int wc, int fr, int fq) const {
        const int row0 = u.pm * BM + wr * 64 + fr, col0 = u.pn * BM + wc * 32 + 4 * fq;
        const int bi = (u.pm < 32) ? 8 : ((u.pm - 32) >> 3);
        const float* gp = gate + (size_t)bi * gstride + col0;
        f32x4 gv[2][2];
#pragma unroll
        for (int bj = 0; bj < 2; ++bj)
#pragma unroll
            for (int n = 0; n < 2; ++n) gv[bj][n] = *(const f32x4*)(gp + bj * HALF + n * 16);
#pragma unroll
        for (int ai = 0; ai < 2; ++ai)
#pragma unroll
            for (int m = 0; m < 4; ++m) { const int row = row0 + ai * HALF + m * 16;
                const float* xp = (row < nrows_a ? xa + (size_t)row * ldc : xb + (size_t)(row - nrows_a) * ldc) + col0; float* dp = dst + (size_t)row * ldc + col0;
#pragma unroll
                for (int bj = 0; bj < 2; ++bj)
#pragma unroll
                    for (int n = 0; n < 2; ++n) { const f32x4 xv = *(const f32x4*)(xp + bj * HALF + n * 16);
                        *(f32x4*)(dp + bj * HALF + n * 16) = xv * alpha + gv[bj][n] * acc[ai][bj][m][n]; } }
    }
};

template <class Epi, class Sched, bool ALIGN_EPI = false, bool SP2 = false>
__device__ __forceinline__ void gemm_phase(PG8_LAS unsigned char* lds, const Gemm g, const Sched& S, const Epi& E) {
    int tid = threadIdx.x; asm volatile("" : "+v"(tid)); const int wid = __builtin_amdgcn_readfirstlane(tid >> 6), lane = tid & 63, wr = wid >> 2, wc = wid & 3, fr = lane & 15, fq = lane >> 4;
    const int K = g.K, nt = K / BK;
    unsigned voffA[2], voffB[2];
#pragma unroll
    for (int i = 0; i < 2; ++i) { int R, C; stage_rc(tid * 16 + i * 8192, R, C); const int Rb = Epi::PERM ? ((R & ~31) + perm32(R & 31)) : R;
        voffA[i] = (unsigned)(R * K + C) * 2u; voffB[i] = (unsigned)(Rb * K + C) * 2u; }
    const size_t kstep = (size_t)(BK * 2);
    const size_t hstep = (size_t)HALF * K * 2;
    const size_t tstep = 2 * hstep;
    const unsigned ldsw = (unsigned)wid * 1024u;
    const int aoff = lds_byte(wr * 64 + fr, fq * 8), boff = lds_byte(wc * 32 + fr, fq * 8);
#define PG8_SA(b, h) (((b) * 2 + (h)) * HTB)
#define PG8_SB(b, h) ((4 + (b) * 2 + (h)) * HTB)
#define PG8_STAGE(bufoff, gbase, voff) do { _Pragma("unroll") for (int _i = 0; _i < 2; ++_i) \
        __builtin_amdgcn_global_load_lds((const unsigned*)((const char*)(gbase) + (voff)[_i]), (PG8_LAS unsigned*)(lds + (bufoff) + ldsw + _i * 8192), 16, 0, 0); } while (0)
#define PG8_LDA(dst, b, h) do { _Pragma("unroll") for (int m = 0; m < 4; ++m) _Pragma("unroll") for (int k = 0; k < 2; ++k) dst[m][k] = *(const PG8_LAS bf16x8*)(lds + PG8_SA(b, h) + aoff + m * 2048 + k * 1024); } while (0)
#define PG8_LDB(dst, b, h) do { _Pragma("unroll") for (int n = 0; n < 2; ++n) _Pragma("unroll") for (int k = 0; k < 2; ++k) dst[n][k] = *(const PG8_LAS bf16x8*)(lds + PG8_SB(b, h) + boff + n * 2048 + k * 1024); } while (0)
#define PG8_MMA(ai, bj, At, Bt) do { __builtin_amdgcn_s_setprio(1); _Pragma("unroll") for (int m = 0; m < 4; ++m) _Pragma("unroll") for (int n = 0; n < 2; ++n) _Pragma("unroll") for (int k = 0; k < 2; ++k) \
        acc[ai][bj][m][n] = __builtin_amdgcn_mfma_f32_16x16x32_bf16(Bt[n][k], At[m][k], acc[ai][bj][m][n], 0, 0, 0); __builtin_amdgcn_s_setprio(0); } while (0)
#define PG8_WAIT_V(n) asm volatile("s_waitcnt vmcnt(" #n ")" ::: "memory")
#define PG8_WAIT_L(n) asm volatile("s_waitcnt lgkmcnt(" #n ")" ::: "memory")
#define PG8_BAR __builtin_amdgcn_s_barrier()
#define PG8_SCHED __builtin_amdgcn_sched_barrier(0)
    Unit cur, nxt; int ui = 0;
    if (!S.next(0, cur)) return;
    f32x4 acc[2][2][4][2];
#pragma unroll
    for (int a = 0; a < 2; ++a)
#pragma unroll
        for (int b = 0; b < 2; ++b)
#pragma unroll
            for (int m = 0; m < 4; ++m)
#pragma unroll
                for (int n = 0; n < 2; ++n) acc[a][b][m][n] = (f32x4){0.f, 0.f, 0.f, 0.f};
    bf16x8 At[4][2], B0[2][2], B1[2][2];
    const char* cA = (const char*)g.A + (size_t)cur.pm * tstep; const char* cB = (const char*)g.Bt + (size_t)cur.pn * tstep;
    S.a_ready(cur);
    if constexpr (SP2) {
        PG8_STAGE(PG8_SB(0, 0), cB, voffB); PG8_STAGE(PG8_SB(0, 1), cB + hstep, voffB); PG8_STAGE(PG8_SA(0, 0), cA, voffA); PG8_STAGE(PG8_SA(0, 1), cA + hstep, voffA);
        if (wr == 1) PG8_BAR;
        PG8_WAIT_V(2); PG8_BAR;
        PG8_STAGE(PG8_SB(1, 0), cB + kstep, voffB); PG8_STAGE(PG8_SA(1, 0), cA + kstep, voffA); PG8_STAGE(PG8_SB(1, 1), cB + hstep + kstep, voffB);
        PG8_WAIT_V(6); PG8_BAR;
    } else {
        PG8_STAGE(PG8_SB(0, 0), cB, voffB); PG8_STAGE(PG8_SA(0, 0), cA, voffA); PG8_STAGE(PG8_SB(0, 1), cB + hstep, voffB); PG8_STAGE(PG8_SA(0, 1), cA + hstep, voffA);
        if (wr == 1) PG8_BAR;
        PG8_WAIT_V(4); PG8_BAR;
        PG8_STAGE(PG8_SB(1, 0), cB + kstep, voffB); PG8_STAGE(PG8_SA(1, 0), cA + kstep, voffA); PG8_STAGE(PG8_SB(1, 1), cB + hstep + kstep, voffB);
        PG8_WAIT_V(6); PG8_BAR;
    }
    for (;;) {
        const bool has_next = S.next(ui + 1, nxt);
        const char* nA = has_next ? (const char*)g.A + (size_t)nxt.pm * tstep : cA; const char* nB = has_next ? (const char*)g.Bt + (size_t)nxt.pn * tstep : cB;
        for (int t = 0; t < nt; t += 2) {
            const bool last = (t == nt - 2);
            const char* a1 = cA + (size_t)(t + 1) * kstep;
            const char* a2 = last ? nA : cA + (size_t)(t + 2) * kstep; const char* b2 = last ? nB : cB + (size_t)(t + 2) * kstep;
            const char* a3 = a2 + kstep; const char* b3 = b2 + kstep;
            if (last && has_next) S.a_ready(nxt);
            if constexpr (SP2) {
            PG8_LDB(B0, 0, 0); PG8_LDB(B1, 0, 1); PG8_SCHED; PG8_LDA(At, 0, 0); PG8_STAGE(PG8_SA(1, 1), a1 + hstep, voffA);
            PG8_WAIT_V(8); PG8_WAIT_L(0); PG8_BAR; PG8_MMA(0, 0, At, B0); PG8_MMA(0, 1, At, B1); PG8_BAR; PG8_SCHED;
            PG8_LDA(At, 0, 1); PG8_STAGE(PG8_SB(0, 0), b2, voffB); PG8_STAGE(PG8_SB(0, 1), b2 + hstep, voffB); PG8_STAGE(PG8_SA(0, 0), a2, voffA);
            PG8_WAIT_V(8); PG8_WAIT_L(0); PG8_BAR; PG8_MMA(1, 0, At, B0); PG8_MMA(1, 1, At, B1); PG8_BAR; PG8_SCHED;
            PG8_LDB(B0, 1, 0); PG8_LDB(B1, 1, 1); PG8_SCHED; PG8_LDA(At, 1, 0); PG8_STAGE(PG8_SA(0, 1), a2 + hstep, voffA);
            PG8_WAIT_V(8); PG8_WAIT_L(0); PG8_BAR; PG8_MMA(0, 0, At, B0); PG8_MMA(0, 1, At, B1); PG8_BAR; PG8_SCHED;
            PG8_LDA(At, 1, 1); PG8_STAGE(PG8_SB(1, 0), b3, voffB); PG8_STAGE(PG8_SB(1, 1), b3 + hstep, voffB); PG8_STAGE(PG8_SA(1, 0), a3, voffA);
            PG8_WAIT_V(8); PG8_WAIT_L(0); PG8_BAR; PG8_MMA(1, 0, At, B0); PG8_MMA(1, 1, At, B1); PG8_BAR; PG8_SCHED;
            } else {
            PG8_LDB(B0, 0, 0); PG8_SCHED; PG8_LDA(At, 0, 0); PG8_STAGE(PG8_SA(1, 1), a1 + hstep, voffA);
            PG8_WAIT_L(8); PG8_BAR; PG8_WAIT_L(0); PG8_MMA(0, 0, At, B0); PG8_BAR; PG8_SCHED;
            PG8_LDB(B1, 0, 1); PG8_STAGE(PG8_SB(0, 0), b2, voffB);
            PG8_BAR; PG8_WAIT_L(0); PG8_MMA(0, 1, At, B1); PG8_BAR;
            PG8_LDA(At, 0, 1); PG8_STAGE(PG8_SA(0, 0), a2, voffA);
            PG8_BAR; PG8_WAIT_L(0); PG8_MMA(1, 0, At, B0); PG8_BAR; PG8_SCHED;
            PG8_STAGE(PG8_SB(0, 1), b2 + hstep, voffB);
            PG8_WAIT_V(6); PG8_BAR; PG8_MMA(1, 1, At, B1); PG8_BAR;
            PG8_LDB(B0, 1, 0); PG8_SCHED; PG8_LDA(At, 1, 0); PG8_STAGE(PG8_SA(0, 1), a2 + hstep, voffA);
            PG8_WAIT_L(8); PG8_BAR; PG8_WAIT_L(0); PG8_MMA(0, 0, At, B0); PG8_BAR; PG8_SCHED;
            PG8_LDB(B1, 1, 1); PG8_STAGE(PG8_SB(1, 0), b3, voffB);
            PG8_BAR; PG8_WAIT_L(0); PG8_MMA(0, 1, At, B1); PG8_BAR;
            PG8_LDA(At, 1, 1); PG8_STAGE(PG8_SA(1, 0), a3, voffA);
            PG8_BAR; PG8_WAIT_L(0); PG8_MMA(1, 0, At, B0); PG8_BAR; PG8_SCHED;
            PG8_STAGE(PG8_SB(1, 1), b3 + hstep, voffB);
            PG8_WAIT_V(6); PG8_BAR; PG8_MMA(1, 1, At, B1); PG8_BAR;
            }
        }
        if constexpr (ALIGN_EPI) { if (wr == 0) PG8_BAR; }
        if constexpr (!Epi::AFTER_DRAIN) { E(acc, cur, wr, wc, fr, fq); S.done(cur); }
        if (!has_next) break;
#pragma unroll
        for (int a = 0; a < 2; ++a)
#pragma unroll
            for (int b = 0; b < 2; ++b)
#pragma unroll
                for (int m = 0; m < 4; ++m)
#pragma unroll
                    for (int n = 0; n < 2; ++n) acc[a][b][m][n] = (f32x4){0.f, 0.f, 0.f, 0.f};
        cur = nxt; cA = nA; cB = nB; ++ui;
        if constexpr (ALIGN_EPI) { if (wr == 1) PG8_BAR; }
    }
    PG8_WAIT_V(0);
    if constexpr (!ALIGN_EPI) { if (wr == 0) PG8_BAR; }
    PG8_BAR;
    if constexpr (Epi::AFTER_DRAIN) { E.fused(acc, cur, wr, wc, fr, fq, lds, wid, lane); S.done(cur); }
#undef PG8_SA
#undef PG8_SB
#undef PG8_STAGE
#undef PG8_LDA
#undef PG8_LDB
#undef PG8_MMA
#undef PG8_WAIT_V
#undef PG8_WAIT_L
#undef PG8_BAR
#undef PG8_SCHED
}
}

#define XB_TMO      128
#define XB_XCNT(j)  (256  + 64 * (j))
#define XB_XSUB(j)  (1280 + 64 * (j))
#define XB_XGEN(j)  (2304 + 64 * (j))
#define XB_TOP      3328
#define XB_TOPGEN   3392
#define XCD_BAR_WORDS 3456
#define XB_SPIN_CAP (1u << 18)

__device__ __forceinline__ unsigned xb_ld(unsigned* p)              { return __hip_atomic_load(p, __ATOMIC_RELAXED, __HIP_MEMORY_SCOPE_AGENT); }
__device__ __forceinline__ unsigned xb_add(unsigned* p, unsigned v) { return __hip_atomic_fetch_add(p, v, __ATOMIC_RELAXED, __HIP_MEMORY_SCOPE_AGENT); }
__device__ __forceinline__ unsigned xb_xcc_id() { return (unsigned)__builtin_amdgcn_s_getreg((3 << 11) | 20) & 0xFu; }
#define XB_SPIN(cond, bar) do { unsigned _sp = 0; while (cond) { __builtin_amdgcn_s_sleep(1); \
    if ((++_sp & 255u) == 0u) { if (xb_ld(&(bar)[XB_TMO])) break; if (_sp > XB_SPIN_CAP) { atomicAdd(&(bar)[XB_TMO], 1u); break; } } } } while (0)

struct XcdBarrier {
    unsigned* bar; unsigned x;
    volatile LAS unsigned* st;
};

__device__ __forceinline__ XcdBarrier xcd_barrier_post(unsigned* bar, volatile LAS unsigned* st) {
    XcdBarrier b; b.bar = bar; b.x = xb_xcc_id(); b.st = st;
    if (threadIdx.x == 0) (void)xb_add(&bar[XB_XCNT(b.x)], 1u);
    return b;
}
__device__ __forceinline__ void xcd_barrier_complete(unsigned* bar, unsigned x, unsigned& nloc, unsigned& nx) {
    const unsigned G = gridDim.x * gridDim.y * gridDim.z;
    unsigned sum, cnt, mine, sp = 0u;
    for (;;) {
        sum = 0u; cnt = 0u; mine = 0u;
#pragma unroll
        for (unsigned j = 0; j < 16; ++j) { const unsigned c = xb_ld(&bar[XB_XCNT(j)]); sum += c; cnt += (c > 0u) ? 1u : 0u; mine = (j == x) ? c : mine; }
        if (sum == G) break;
        __builtin_amdgcn_s_sleep(1);
        if ((++sp & 255u) == 0u) { if (xb_ld(&bar[XB_TMO])) break; if (sp > XB_SPIN_CAP) { atomicAdd(&bar[XB_TMO], 1u); break; } }
    }
    nloc = mine > 0u ? mine : 1u; nx = cnt > 0u ? cnt : 1u;
}

__device__ __forceinline__ void xcd_barrier(const XcdBarrier& b) {
    asm volatile("s_waitcnt vmcnt(0)" ::: "memory");
    __syncthreads();
    if (threadIdx.x == 0) {
        unsigned* bar = b.bar;
        __builtin_amdgcn_s_waitcnt(0);
        unsigned nloc = b.st[0], nx = b.st[1];
        if (nloc == 0u) { xcd_barrier_complete(bar, b.x, nloc, nx); b.st[0] = nloc; b.st[1] = nx; }
        const unsigned old = xb_add(&bar[XB_XSUB(b.x)], 1u);
        const unsigned gen = old / nloc;
        if (old + 1u == (gen + 1u) * nloc) {
            __builtin_amdgcn_fence(__ATOMIC_RELEASE, "agent");
            asm volatile("s_waitcnt vmcnt(0)" ::: "memory");
            const unsigned og = xb_add(&bar[XB_TOP], 1u);
            const unsigned tg = og / nx;
            if (og + 1u == (tg + 1u) * nx) xb_add(&bar[XB_TOPGEN], 1u);
            else XB_SPIN(xb_ld(&bar[XB_TOPGEN]) == tg, bar);
            __builtin_amdgcn_fence(__ATOMIC_ACQUIRE, "agent");
            xb_add(&bar[XB_XGEN(b.x)], 1u);
            asm volatile("s_waitcnt vmcnt(0)" ::: "memory");
        } else {
            XB_SPIN(xb_ld(&bar[XB_XGEN(b.x)]) == gen, bar);
            __builtin_amdgcn_fence(__ATOMIC_ACQUIRE, "agent");
            asm volatile("s_waitcnt vmcnt(0)" ::: "memory");
        }
    }
    __syncthreads();
}


struct Params { const float* in[N_IN]; float* out; unsigned char* ws; };

struct Ctx {
    LAS unsigned char* lds; int tid, lane, wave, G, bid;
    const float* const* in; float* out; unsigned char* ws; unsigned* ctl;
};

__device__ __forceinline__ float wave_sum(float v) {
#pragma unroll
    for (int o = 32; o >= 1; o >>= 1) v += __shfl_xor(v, o);
    return v;
}
template <int CTRL> __device__ __forceinline__ float dpp_f(float x) { return __int_as_float(__builtin_amdgcn_update_dpp(0, __float_as_int(x), CTRL, 0xf, 0xf, false)); }
__device__ __forceinline__ float row16_sum(float x) { x += dpp_f<0x128>(x); x += dpp_f<0x124>(x); x += dpp_f<0x122>(x); x += dpp_f<0x121>(x); return x; }

__device__ __forceinline__ Ctx relaunder(const Ctx& C) { Ctx R = C; int t = C.tid; asm volatile("" : "+v"(t)); R.tid = t; R.lane = t & 63; R.wave = __builtin_amdgcn_readfirstlane(t >> 6); return R; }

__device__ __forceinline__ int queue_pop(const Ctx& C, int qid) {
    volatile LAS int* slot = (volatile LAS int*)(C.lds + LDS_MISC + 16);
    __syncthreads();
    if (C.tid == 0) *slot = (int)__hip_atomic_fetch_add(C.ctl + CW_Q + 64 * qid, 1u, __ATOMIC_RELAXED, __HIP_MEMORY_SCOPE_AGENT);
    __syncthreads();
    return *slot;
}

__device__ __forceinline__ void tr_decode(const Ctx& C, int job, const float*& src, int& ldsrc, bf16*& dst, int& lddst) {
    constexpr int TPL = 12352;
    const int l = job / TPL, ti = job % TPL;
    if (ti < 2944) { const int kt = ti / 92, nt = ti % 92; src = C.in[I_WIN] + (size_t)l * D * INW + (size_t)kt * 64 * INW + nt * 64; ldsrc = INW;
        dst = (bf16*)(C.ws + WS_WIN) + (size_t)l * N1 * D + (size_t)nt * 64 * D + kt * 64; lddst = D; }
    else if (ti < 3072) { const int t = ti - 2944, i = t >> 5, kt = t & 31; src = C.in[(i < 2) ? I_W1 : I_A1] + ((size_t)(l * 2 + (i & 1)) * D + kt * 64) * 64; ldsrc = 64;
        dst = (bf16*)(C.ws + WS_WIN) + (size_t)l * N1 * D + (size_t)(INW + 64 * i) * D + kt * 64; lddst = D; }
    else if (ti < 4096) { const int t = ti - 3072, kt = t >> 5, nt = t & 31; src = C.in[I_WOUT] + (size_t)l * D * D + (size_t)kt * 64 * D + nt * 64; ldsrc = D;
        dst = (bf16*)(C.ws + WS_WOUT) + (size_t)l * D * D + (size_t)nt * 64 * D + kt * 64; lddst = D; }
    else if (ti < 9600) { const int t = ti - 4096, kt = t / 172, nt = t % 172; src = C.in[I_WUP] + (size_t)l * D * NUP + (size_t)kt * 64 * NUP + nt * 64; ldsrc = NUP;
        const int c0 = nt * 64, cb = (c0 < DFF) ? c0 : c0 - DFF, r0 = (cb >> 7) * 256 + ((c0 < DFF) ? 0 : 128) + (cb & 127);
        dst = (bf16*)(C.ws + WS_WUP) + (size_t)l * NUP * D + (size_t)r0 * D + kt * 64; lddst = D; }
    else { const int t = ti - 9600, kt = t >> 5, nt = t & 31; src = C.in[I_WDN] + (size_t)l * DFF * D + (size_t)kt * 64 * D + nt * 64; ldsrc = D;
        dst = (bf16*)(C.ws + WS_WDN) + (size_t)l * D * DFF + (size_t)nt * 64 * DFF + kt * 64; lddst = DFF; }
}
__device__ __forceinline__ void p0_transposes(const Ctx& C) {
    constexpr int TPL = 12352, NT = DEPTH * TPL, TB = 8;
    LAS float* tiles = (LAS float*)C.lds;
    const int tid = C.tid;
    for (int jb = C.bid; jb * TB < NT; jb += C.G) {
        f32x4 v[TB][2];
#pragma unroll
        for (int q = 0; q < TB; ++q) { const int job = jb * TB + q; if (job < NT) { const float* src; int ldsrc; bf16* dst; int lddst; tr_decode(C, job, src, ldsrc, dst, lddst);
#pragma unroll
            for (int p = 0; p < 2; ++p) v[q][p] = *(const f32x4*)(src + (size_t)(p * 32 + (tid >> 4)) * ldsrc + (tid & 15) * 4); } }
        __syncthreads();
#pragma unroll
        for (int q = 0; q < TB; ++q) { LAS float* tile = tiles + q * (64 * 65);
#pragma unroll
            for (int p = 0; p < 2; ++p) { const int k = p * 32 + (tid >> 4), n4 = (tid & 15) * 4; tile[k * 65 + n4 + 0] = v[q][p][0]; tile[k * 65 + n4 + 1] = v[q][p][1]; tile[k * 65 + n4 + 2] = v[q][p][2]; tile[k * 65 + n4 + 3] = v[q][p][3]; } }
        __syncthreads();
#pragma unroll
        for (int q = 0; q < TB; ++q) { const int job = jb * TB + q; if (job < NT) { const float* src; int ldsrc; bf16* dst; int lddst; tr_decode(C, job, src, ldsrc, dst, lddst);
            const LAS float* tile = tiles + q * (64 * 65); const int n = tid >> 3, k8 = (tid & 7) * 8; float f[8];
#pragma unroll
            for (int j = 0; j < 8; ++j) f[j] = tile[(k8 + j) * 65 + n];
            u32x4 w; w.x = pk2(f[0], f[1]); w.y = pk2(f[2], f[3]); w.z = pk2(f[4], f[5]); w.w = pk2(f[6], f[7]);
            *(u32x4*)(dst + (size_t)n * lddst + k8) = w; } }
    }
    __syncthreads();
}

__device__ __forceinline__ void p0_wl2(const Ctx& C) {
    const int total = DEPTH * 3072 * 32;
    for (int idx = C.bid * 512 + C.tid; idx < total; idx += C.G * 512) {
        const int l = idx / (3072 * 32), rem = idx % (3072 * 32), n = rem >> 5, k8 = (rem & 31) * 8;
        const int blk = n / 768, j = n % 768, kb = k8 >> 6, kk0 = k8 & 63;
        u32x4 w = (u32x4){0u, 0u, 0u, 0u};
        if (kb == blk) { const float* s = C.in[(blk < 2) ? I_W2 : I_A2] + ((size_t)(l * 2 + (blk & 1)) * 64 + kk0) * 768 + j; float f[8];
#pragma unroll
            for (int e = 0; e < 8; ++e) f[e] = s[(size_t)e * 768];
            w.x = pk2(f[0], f[1]); w.y = pk2(f[2], f[3]); w.z = pk2(f[4], f[5]); w.w = pk2(f[6], f[7]); }
        *(u32x4*)((bf16*)(C.ws + WS_WL2) + ((size_t)l * 3072 + n) * 256 + k8) = w;
    }
}

__device__ __forceinline__ void p0_mod(const Ctx& C) {
    LAS float* sc = (LAS float*)C.lds;
    LAS float* red = (LAS float*)(C.lds + 9 * 2048 * 4);
    __syncthreads();
    for (int i = C.tid; i < 9 * 2048; i += 512) { const int bi = i >> 11, k = i & 2047; const float x = (bi < 8) ? C.in[I_C][bi * 2048 + k] : C.in[I_CCTX][k]; sc[i] = siluf_(x); }
    __syncthreads();
    const int cg = C.tid & 15, kg = C.tid >> 4;
    for (int unit = C.bid; unit < DEPTH * 192; unit += C.G) {
        const int l = unit / 192, cb = (unit % 192) * 64;
        f32x4 acc[9];
#pragma unroll
        for (int bi = 0; bi < 9; ++bi) acc[bi] = (f32x4){0.f, 0.f, 0.f, 0.f};
        const float* wp = C.in[I_WMOD] + ((size_t)l * D + kg * 64) * NMOD + cb + cg * 4;
#pragma unroll 8
        for (int kk = 0; kk < 64; ++kk) { const f32x4 w = *(const f32x4*)(wp + (size_t)kk * NMOD);
#pragma unroll
            for (int bi = 0; bi < 9; ++bi) acc[bi] += w * sc[bi * 2048 + kg * 64 + kk]; }
#pragma unroll
        for (int bi = 0; bi < 9; ++bi)
#pragma unroll
            for (int e = 0; e < 4; ++e) { float v = acc[bi][e]; v += __shfl_xor(v, 16); v += __shfl_xor(v, 32); if (C.lane < 16) red[(C.wave * 9 + bi) * 64 + cg * 4 + e] = v; }
        __syncthreads();
        for (int idx = C.tid; idx < 9 * 64; idx += 512) { const int bi = idx >> 6, c = idx & 63; float s = C.in[I_BMOD][l * NMOD + cb + c];
#pragma unroll
            for (int w = 0; w < 8; ++w) s += red[(w * 9 + bi) * 64 + c];
            ((float*)(C.ws + WS_MOD))[((size_t)l * 9 + bi) * NMOD + cb + c] = s; }
        __syncthreads();
    }
}

__device__ __forceinline__ void p0_filters(const Ctx& C) {
    LAS float* z = (LAS float*)C.lds;
    LAS float* h1 = z + 16 * 33;
    LAS float* h2 = h1 + 16 * 64;
    const float HY_MIN = -3.0701134573253945f, HY_MAX = -15.350567286626973f;
    for (int unit = C.bid; unit < DEPTH * 144; unit += C.G) {
        const int l = unit / 144, u2 = unit % 144, grp = (u2 < 128) ? 0 : 1, jb = grp ? (u2 - 128) : u2, L = grp ? 256 : 2048, j0 = jb * 16;
        __syncthreads();
        for (int idx = C.tid; idx < 16 * 33; idx += 512) { const int jj = idx / 33, e = idx % 33, j = j0 + jj; float v;
            if (e == 0) v = (float)j / (float)(L - 1);
            else { const int band = (e - 1) & 15; const float f = 1e-4f + (float)band * ((15.0f - 1e-4f) / 15.0f); const float ang = 6.283185307179586f * (float)j * f / (float)L; v = (e <= 16) ? cosf(ang) : sinf(ang); }
            z[idx] = v; }
        __syncthreads();
        for (int idx = C.tid; idx < 1024; idx += 512) { const int jj = idx >> 6, o = idx & 63; float s = C.in[I_FB1][l * 64 + o];
            for (int e = 0; e < 33; ++e) s += z[jj * 33 + e] * C.in[I_FW1][((size_t)l * 33 + e) * 64 + o];
            h1[idx] = sinf(C.in[I_FF1][l * 64 + o] * s); }
        __syncthreads();
        for (int idx = C.tid; idx < 1024; idx += 512) { const int jj = idx >> 6, o = idx & 63; float s = C.in[I_FB2][l * 64 + o];
            for (int e = 0; e < 64; ++e) s += h1[jj * 64 + e] * C.in[I_FW2][((size_t)l * 64 + e) * 64 + o];
            h2[idx] = sinf(C.in[I_FF2][l * 64 + o] * s); }
        __syncthreads();
        const int col = C.tid * 4, o = col >> 10, dir = (col >> 9) & 1, c0 = col & 511;
        f32x4 acc[16];
#pragma unroll
        for (int jj = 0; jj < 16; ++jj) acc[jj] = (f32x4){0.f, 0.f, 0.f, 0.f};
        for (int i = 0; i < 64; ++i) { const f32x4 w = *(const f32x4*)(C.in[I_FW3] + ((size_t)l * 64 + i) * 2048 + col);
#pragma unroll
            for (int jj = 0; jj < 16; ++jj) acc[jj] += w * h2[jj * 64 + i]; }
        bf16* fb = (bf16*)(C.ws + WS_FILT + (size_t)l * FILT_LAYER + (grp ? FILT_CTX_OFF : 0));
#pragma unroll
        for (int jj = 0; jj < 16; ++jj) { const int j = j0 + jj; const float t = (float)j / (float)(L - 1);
#pragma unroll
            for (int e = 0; e < 4; ++e) { const int c = c0 + e; const float delta = fabsf(HY_MIN + (float)c * ((HY_MAX - HY_MIN) / 511.0f));
                float val = acc[jj][e] * expf(-t * delta); int eidx = dir ? (L + j) : (L - j);
                if (dir && j == 0) { eidx = 0; val = 0.f; }
                fb[((size_t)(o * 512 + c)) * (2 * L) + eidx] = (bf16)f2bf(val); } }
    }
}

__device__ __forceinline__ void p0_rope(const Ctx& C) {
    float* rc = (float*)(C.ws + WS_ROPE);
    for (int idx = C.bid * 512 + C.tid; idx < 2048 * 32; idx += C.G * 512) { const int t = idx >> 5, i = idx & 31; const float inv = exp2f(-(float)(i & 15) * (13.287712379549449f / 16.0f));
        const float ang = (float)((i < 16) ? (t >> 6) : (t & 63)) * inv; rc[idx] = cosf(ang); rc[65536 + idx] = sinf(ang); }
}

__device__ __forceinline__ void p0_h0(const Ctx& C) {
    const float* mod = (const float*)(C.ws + WS_MOD);
    bf16* H = (bf16*)(C.ws + WS_H);
    const int total = M * (D / 8);
    for (int task = C.bid * 512 + C.tid; task < total; task += C.G * 512) {
        const int row = task >> 8, c8 = (task & 255) * 8;
        const float* xp = (row < MC) ? C.in[I_XP] + (size_t)row * D + c8 : C.in[I_XS] + (size_t)(row - MC) * D + c8;
        const int bi = (row < MC) ? 8 : ((row - MC) >> 11);
        const float* mp = mod + (size_t)bi * NMOD + c8;
        const f32x4 x0 = *(const f32x4*)xp, x1 = *(const f32x4*)(xp + 4), sh0 = *(const f32x4*)mp, sh1 = *(const f32x4*)(mp + 4), s0 = *(const f32x4*)(mp + D), s1 = *(const f32x4*)(mp + D + 4);
        const f32x4 h0 = x0 * (s0 + 1.0f) + sh0, h1 = x1 * (s1 + 1.0f) + sh1;
        u32x4 w; w.x = pk2(h0[0], h0[1]); w.y = pk2(h0[2], h0[3]); w.z = pk2(h1[0], h1[1]); w.w = pk2(h1[2], h1[3]);
        *(u32x4*)(H + (size_t)row * D + c8) = w;
    }
}

__device__ __forceinline__ void ln_phase(const Ctx& C, float* buf, const float* g, const float* b, const float* modl  , int shift_off, int scale_off, bf16* H) {
    const int lane = C.lane;
    f32x4 gv[8], bv[8];
#pragma unroll
    for (int i = 0; i < 8; ++i) { gv[i] = *(const f32x4*)(g + lane * 4 + 256 * i); bv[i] = *(const f32x4*)(b + lane * 4 + 256 * i); }
    for (int row = C.bid * 8 + C.wave; row < M; row += C.G * 8) {
        float* rp = buf + (size_t)row * D + lane * 4;
        f32x4 v[8]; float s = 0.f;
#pragma unroll
        for (int i = 0; i < 8; ++i) { v[i] = *(const f32x4*)(rp + 256 * i); s += (v[i][0] + v[i][1]) + (v[i][2] + v[i][3]); }
        const float mu = wave_sum(s) * (1.0f / 2048.0f);
        float q = 0.f;
#pragma unroll
        for (int i = 0; i < 8; ++i) { v[i] = v[i] - mu; q += (v[i][0] * v[i][0] + v[i][1] * v[i][1]) + (v[i][2] * v[i][2] + v[i][3] * v[i][3]); }
        const float rstd = rsqrtf(wave_sum(q) * (1.0f / 2048.0f) + LN_EPS);
        const int bi = (row < MC) ? 8 : ((row - MC) >> 11);
#pragma unroll
        for (int i = 0; i < 8; ++i) { const f32x4 y = v[i] * rstd * gv[i] + bv[i]; *(f32x4*)(rp + 256 * i) = y;
            if (modl) { const float* mp = modl + (size_t)bi * NMOD + lane * 4 + 256 * i; const f32x4 sh = *(const f32x4*)(mp + shift_off), sc = *(const f32x4*)(mp + scale_off);
                const f32x4 h = y * (sc + 1.0f) + sh; u32x2 w; w.x = pk2(h[0], h[1]); w.y = pk2(h[2], h[3]); *(u32x2*)(H + (size_t)row * D + lane * 4 + 256 * i) = w; } }
    }
}

__device__ __forceinline__ void gate_fixup_phase(const Ctx& C, const float* halo, const float* cw, bf16* Gb) {
    for (int idx = C.bid * 512 + C.tid; idx < 56 * DFF; idx += C.G * 512) {
        const int seam = idx / DFF, j = idx % DFF, p = 32 + (seam / 7) * 8 + (seam % 7);
        const float* h0 = halo + (size_t)p * 4 * 11008; const float* h1 = halo + (size_t)(p + 1) * 4 * 11008;
        const float a254 = h0[2 * 11008 + j], a255 = h0[3 * 11008 + j], a0 = h1[j], a1 = h1[11008 + j];
        const float b254 = h0[2 * 11008 + 5504 + j], b255 = h0[3 * 11008 + 5504 + j], b0 = h1[5504 + j], b1 = h1[11008 + 5504 + j];
        const float wa0 = cw[j], wa1 = cw[11008 + j], wa2 = cw[2 * 11008 + j], wb0 = cw[5504 + j], wb1 = cw[11008 + 5504 + j], wb2 = cw[2 * 11008 + 5504 + j];
        const float ca = wa0 * a254 + wa1 * a255 + wa2 * a0, cb = wb0 * b254 + wb1 * b255 + wb2 * b0;
        const float da = wa0 * a255 + wa1 * a0 + wa2 * a1, db = wb0 * b255 + wb1 * b0 + wb2 * b1;
        Gb[(size_t)(p * 256 + 255) * DFF + j] = (bf16)f2bf(ca * __builtin_amdgcn_rcpf(1.0f + __expf(-ca)) * cb);
        Gb[(size_t)((p + 1) * 256) * DFF + j] = (bf16)f2bf(da * __builtin_amdgcn_rcpf(1.0f + __expf(-da)) * db);
    }
}

constexpr int AT_KS = 72;
constexpr int AT_VS = 72;
constexpr int AT_KOFF = 0, AT_VOFF = 64 * AT_KS * 2;

constexpr int AT_BUF = 2 * 64 * AT_KS * 2;
struct AttnRegs { u32x4 a, b, c, d; };
__device__ __forceinline__ void attn_load(const Ctx& C, AttnRegs& R, bool f32src, const void* kptr, const void* vptr, int ld, bool rope, int tpos0, const float* ropec) {
    const int key = C.tid & 63, part = C.tid >> 6;
    if (f32src) {
        const float* kp = (const float*)kptr + (size_t)key * ld + part * 8; const float* vp = (const float*)vptr + (size_t)key * ld + part * 8;
        R.a = *(const u32x4*)kp; R.b = *(const u32x4*)(kp + 4); R.c = *(const u32x4*)vp; R.d = *(const u32x4*)(vp + 4);
    } else {
        const bf16* kp = (const bf16*)kptr + (size_t)key * ld + part * 8; const bf16* vp = (const bf16*)vptr + (size_t)key * ld + part * 8;
        R.a = *(const u32x4*)kp; R.b = *(const u32x4*)vp;
        if (rope) R.c = *(const u32x4*)((const bf16*)kptr + (size_t)key * ld + (part ^ 4) * 8);
    }
}
__device__ __forceinline__ void attn_write(const Ctx& C, const AttnRegs& R, bool f32src, bool rope, LAS unsigned char* buf, int tpos0, const float* ropec) {
    LAS bf16* Kc = (LAS bf16*)(buf + AT_KOFF); LAS bf16* Vt = (LAS bf16*)(buf + AT_VOFF);
    const int key = C.tid & 63, part = C.tid >> 6;
    float kf[8], vf[8];
    if (f32src) {
#pragma unroll
        for (int e = 0; e < 4; ++e) { kf[e] = __uint_as_float(R.a[e]); kf[4 + e] = __uint_as_float(R.b[e]); vf[e] = __uint_as_float(R.c[e]); vf[4 + e] = __uint_as_float(R.d[e]); }
    } else {
#pragma unroll
        for (int e = 0; e < 4; ++e) { kf[2 * e] = bflo(R.a[e]); kf[2 * e + 1] = bfhi(R.a[e]); vf[2 * e] = bflo(R.b[e]); vf[2 * e + 1] = bfhi(R.b[e]); }
        if (rope) {
            const float* cp = ropec + (size_t)(tpos0 + key) * 32 + (part & 3) * 8; const f32x4 cs0 = *(const f32x4*)cp, cs1 = *(const f32x4*)(cp + 4), sn0 = *(const f32x4*)(cp + 65536), sn1 = *(const f32x4*)(cp + 65536 + 4);
#pragma unroll
            for (int e = 0; e < 8; ++e) { const float other = (e & 1) ? bfhi(R.c[e >> 1]) : bflo(R.c[e >> 1]); const float cs = (e < 4) ? cs0[e & 3] : cs1[e & 3], sn = (e < 4) ? sn0[e & 3] : sn1[e & 3];
                kf[e] = (part < 4) ? (kf[e] * cs - other * sn) : (other * sn + kf[e] * cs); }
        }
    }
    u32x4 w; w.x = pk2(kf[0], kf[1]); w.y = pk2(kf[2], kf[3]); w.z = pk2(kf[4], kf[5]); w.w = pk2(kf[6], kf[7]);
    *(LAS u32x4*)(Kc + key * AT_KS + part * 8) = w;
    const unsigned v01 = pk2(vf[0], vf[1]), v23 = pk2(vf[2], vf[3]), v45 = pk2(vf[4], vf[5]), v67 = pk2(vf[6], vf[7]);
    Vt[(part * 8 + 0) * AT_VS + key] = (bf16)v01; Vt[(part * 8 + 1) * AT_VS + key] = (bf16)(v01 >> 16); Vt[(part * 8 + 2) * AT_VS + key] = (bf16)v23; Vt[(part * 8 + 3) * AT_VS + key] = (bf16)(v23 >> 16);
    Vt[(part * 8 + 4) * AT_VS + key] = (bf16)v45; Vt[(part * 8 + 5) * AT_VS + key] = (bf16)(v45 >> 16); Vt[(part * 8 + 6) * AT_VS + key] = (bf16)v67; Vt[(part * 8 + 7) * AT_VS + key] = (bf16)(v67 >> 16);
}

__device__ __forceinline__ void attn_item3(const Ctx& C, int layer, bool latent, int b, int hk, int qblk) {
    const bf16* qkv = (const bf16*)(C.ws + WS_QKV);
    bf16* mix = (bf16*)(C.ws + WS_MIX);
    const float* ropec = (const float*)(C.ws + WS_ROPE);
    const int T = latent ? T_D : T_C, row_base = latent ? MC + b * T_D : b * T_C, q0 = qblk * 256;
    const int lane = C.lane, n = lane & 31, hh = lane >> 5, qw = q0 + C.wave * 32, qpos = qw + n;
    const float LOG2E = 1.4426950408889634f;
    float sink2[3];
#pragma unroll
    for (int g = 0; g < 3; ++g) sink2[g] = C.in[I_SINK][layer * AH + hk * 3 + g] * LOG2E;
    LAS unsigned char* qs_lds = C.lds + 2 * AT_BUF + C.wave * (3 * 4 * 1024) + lane * 16;
#pragma unroll
    for (int g = 0; g < 3; ++g) { const bf16* qp = qkv + (size_t)(row_base + qpos) * NQKV + (hk * 3 + g) * 64 + 8 * hh; float q[4][8];
#pragma unroll
      for (int ks = 0; ks < 4; ++ks) { const u32x4 a = *(const u32x4*)(qp + 16 * ks);
#pragma unroll
          for (int e = 0; e < 4; ++e) { q[ks][2 * e] = bflo(a[e]); q[ks][2 * e + 1] = bfhi(a[e]); } }
      if (latent) {
#pragma unroll
          for (int ks = 0; ks < 2; ++ks) { const float* cp = ropec + (size_t)qpos * 32 + 16 * ks + 8 * hh; const float* sp = cp + 65536;
#pragma unroll
              for (int e = 0; e < 8; ++e) { const float x1 = q[ks][e], x2 = q[ks + 2][e], cs = cp[e], sn = sp[e]; q[ks][e] = x1 * cs - x2 * sn; q[ks + 2][e] = x1 * sn + x2 * cs; } } }
      const float qs = 0.125f * LOG2E;
#pragma unroll
      for (int ks = 0; ks < 4; ++ks) { u32x4 w; w.x = pk2(q[ks][0] * qs, q[ks][1] * qs); w.y = pk2(q[ks][2] * qs, q[ks][3] * qs); w.z = pk2(q[ks][4] * qs, q[ks][5] * qs); w.w = pk2(q[ks][6] * qs, q[ks][7] * qs);
          *(LAS u32x4*)(qs_lds + (g * 4 + ks) * 1024) = w; } }
    f32x16 oacc[3][2]; float mrun[3], lrun[3];
#pragma unroll
    for (int g = 0; g < 3; ++g) { mrun[g] = sink2[g]; lrun[g] = 0.f;
#pragma unroll
        for (int i = 0; i < 16; ++i) { oacc[g][0][i] = 0.f; oacc[g][1][i] = 0.f; } }
    int nloc, kc0;
    if (latent) { const int lo = (q0 - 128 > 0) ? q0 - 128 : 0, hi = (q0 + 384 < T) ? q0 + 384 : T; kc0 = lo >> 6; nloc = (hi - lo) >> 6; } else { kc0 = 0; nloc = 4; }
    const int nch = nloc + (latent ? 8 : 0);
    AttnRegs R;
    auto chunk_src = [&](int ch, bool& f32src, const void*& kp, const void*& vp, int& ld, int& key0) {
        const bool loc = ch < nloc; key0 = loc ? (kc0 + ch) * 64 : (ch - nloc) * 64; f32src = !loc;
        if (loc) { const bf16* p = qkv + (size_t)(row_base + key0) * NQKV + 768 + hk * 64; kp = p; vp = p + 256; ld = NQKV; }
        else { const size_t off = (((size_t)b * DEPTH + layer) * PAST + key0) * KVW + hk * 64; kp = C.in[I_CK] + off; vp = C.in[I_CV] + off; ld = KVW; } };
    { bool f; const void* kp; const void* vp; int ld, k0; chunk_src(0, f, kp, vp, ld, k0); attn_load(C, R, f, kp, vp, ld, latent && !f, k0, ropec); }
    __syncthreads();
    for (int ch = 0; ch < nch; ++ch) {
        const bool loc = ch < nloc;
        const int key0 = loc ? (kc0 + ch) * 64 : (ch - nloc) * 64;
        LAS unsigned char* buf = C.lds + (ch & 1) * AT_BUF;
        attn_write(C, R, !loc, latent && loc, buf, key0, ropec);
        __syncthreads();
        if (ch + 1 < nch) { bool f; const void* kp; const void* vp; int ld, k0; chunk_src(ch + 1, f, kp, vp, ld, k0); attn_load(C, R, f, kp, vp, ld, latent && !f, k0, ropec); }
        LAS bf16* Kc = (LAS bf16*)(buf + AT_KOFF); LAS bf16* Vt = (LAS bf16*)(buf + AT_VOFF);
#pragma unroll 1
        for (int tt = 0; tt < 2; ++tt) {
            const int k0t = key0 + 32 * tt;
            if (loc && latent && (k0t + 31 < qw - 128 || k0t > qw + 31 + 128)) continue;
#pragma unroll
            for (int g = 0; g < 3; ++g) {
            __builtin_amdgcn_sched_barrier(0);
            f32x16 s;
#pragma unroll
            for (int i = 0; i < 16; ++i) s[i] = -mrun[g];
#pragma unroll
            for (int ks = 0; ks < 4; ++ks) { const bf16x8 kf = *(const LAS bf16x8*)(Kc + (32 * tt + n) * AT_KS + 16 * ks + 8 * hh); s = __builtin_amdgcn_mfma_f32_32x32x16_bf16(kf, *(const LAS bf16x8*)(qs_lds + (g * 4 + ks) * 1024), s, 0, 0, 0); }
            if (loc && latent && (k0t < qw - 97 || k0t > qw + 97)) {
#pragma unroll
                for (int i = 0; i < 16; ++i) { const int kpos = k0t + (i & 3) + 8 * (i >> 2) + 4 * hh; const int dlt = qpos - kpos; if (dlt > 128 || dlt < -128) s[i] = -1e30f; } }
            float mx = fmaxf(fmaxf(s[0], s[1]), s[2]);
#pragma unroll
            for (int i = 3; i < 15; i += 2) mx = fmaxf(fmaxf(mx, s[i]), s[i + 1]);
            mx = fmaxf(mx, s[15]);
            mx = fmaxf(mx, __shfl_xor(mx, 32));
            if (__builtin_amdgcn_ballot_w64(mx > 8.0f) != 0ull) {
                const float up = fmaxf(mx, 0.f), alpha = exp2f(-up);
                mrun[g] += up; lrun[g] *= alpha;
#pragma unroll
                for (int i = 0; i < 16; ++i) { oacc[g][0][i] *= alpha; oacc[g][1][i] *= alpha; s[i] -= up; }
            }
            float ps = 0.f;
#pragma unroll
            for (int i = 0; i < 16; ++i) { s[i] = __builtin_amdgcn_exp2f(s[i]); ps += s[i]; }
            lrun[g] += ps;
#pragma unroll
            for (int s2 = 0; s2 < 2; ++s2) {
                u32x4 pw; pw.x = pk2(s[8 * s2 + 0], s[8 * s2 + 1]); pw.y = pk2(s[8 * s2 + 2], s[8 * s2 + 3]); pw.z = pk2(s[8 * s2 + 4], s[8 * s2 + 5]); pw.w = pk2(s[8 * s2 + 6], s[8 * s2 + 7]);
                const bf16x8 pf = __builtin_bit_cast(bf16x8, pw);
#pragma unroll
                for (int mt = 0; mt < 2; ++mt) {
                    const LAS bf16* vp = Vt + (32 * mt + n) * AT_VS + 32 * tt + 16 * s2 + 4 * hh;
                    const u32x2 v0 = *(const LAS u32x2*)vp, v1 = *(const LAS u32x2*)(vp + 8);
                    u32x4 vw; vw.x = v0.x; vw.y = v0.y; vw.z = v1.x; vw.w = v1.y;
                    oacc[g][mt] = __builtin_amdgcn_mfma_f32_32x32x16_bf16(__builtin_bit_cast(bf16x8, vw), pf, oacc[g][mt], 0, 0, 0);
                }
            }
            }
        }
    }
#pragma unroll
    for (int g = 0; g < 3; ++g) {
    const float ltot = lrun[g] + __shfl_xor(lrun[g], 32) + exp2f(sink2[g] - mrun[g]), inv = 1.0f / ltot;
    bf16* op = mix + (size_t)(row_base + qpos) * D + 1280 + (hk * 3 + g) * 64;
#pragma unroll
    for (int mt = 0; mt < 2; ++mt)
#pragma unroll
        for (int gg = 0; gg < 4; ++gg) { u32x2 w; w.x = pk2(oacc[g][mt][4 * gg] * inv, oacc[g][mt][4 * gg + 1] * inv); w.y = pk2(oacc[g][mt][4 * gg + 2] * inv, oacc[g][mt][4 * gg + 3] * inv);
            *(u32x2*)(op + 32 * mt + 8 * gg + 4 * hh) = w; }
    }
}

template <int GRP>
__device__ __forceinline__ void hyena_item(const Ctx& C, int layer, int c) {
    constexpr int L = GRP ? 256 : 2048, NBt = GRP ? 32 : 8, NTAU = L / 64, NCOL = NTAU * NBt, NN = GRP ? 1 : 2;
    constexpr int CS = GRP ? 1088 : 8256;
    constexpr int ZOFF = 8 * 8256, ZS = 144, XOFF = ZOFF + (256 + 16) * ZS;
    constexpr int row_base = GRP ? 0 : MC;
    const bf16* hyt = (const bf16*)(C.ws + WS_HYT);
    bf16* hyo = (bf16*)(C.ws + WS_HYO);
    const int tid = C.tid, lane = C.lane, wave = C.wave;
    LAS unsigned char* FC = C.lds; LAS unsigned char* ZB = C.lds + ZOFF; LAS unsigned char* XB = C.lds + XOFF;
    const int i16 = lane & 15, kg = lane >> 4;
    __syncthreads();
    auto load_stream = [&](int stream, LAS unsigned char* dst, int pad) {
        const bf16* src = hyt + (size_t)(stream * 512 + c) * M + row_base;
        const float w0 = C.in[I_HSW][((size_t)layer * 3 + 0) * 1536 + stream * 512 + c], w1 = C.in[I_HSW][((size_t)layer * 3 + 1) * 1536 + stream * 512 + c], w2 = C.in[I_HSW][((size_t)layer * 3 + 2) * 1536 + stream * 512 + c];
        for (int task = tid; task < NBt * L / 8; task += 512) {
            const int b = task / (L / 8), t8 = (task % (L / 8)) * 8;
            const bf16* p = src + b * L + t8;
            const u32x4 a = *(const u32x4*)p; float x[10];
            x[0] = (t8 > 0) ? bf2f(p[-1]) : 0.f; x[9] = (t8 + 8 < L) ? bf2f(p[8]) : 0.f;
#pragma unroll
            for (int e = 0; e < 4; ++e) { x[1 + 2 * e] = bflo(a[e]); x[2 + 2 * e] = bfhi(a[e]); }
            float y[8];
#pragma unroll
            for (int e = 0; e < 8; ++e) y[e] = w0 * x[e] + w1 * x[e + 1] + w2 * x[e + 2];
            u32x4 w; w.x = pk2(y[0], y[1]); w.y = pk2(y[2], y[3]); w.z = pk2(y[4], y[5]); w.w = pk2(y[6], y[7]);
            const int col = (t8 >> 6) * NBt + b, j = t8 & 63;
            *(LAS u32x4*)(dst + (col + pad) * ZS + j * 2) = w;
        }
    };
    auto load_filter = [&](int o) {
        const bf16* g = (const bf16*)(C.ws + WS_FILT + (size_t)layer * FILT_LAYER + (GRP ? FILT_CTX_OFF : 0)) + (size_t)(o * 512 + c) * (2 * L);
        for (int ch = tid; ch < (2 * L + 16) / 8; ch += 512) { u32x4 w = (u32x4){0u, 0u, 0u, 0u}; if (ch < 2 * L / 8) w = *(const u32x4*)(g + ch * 8); *(LAS u32x4*)(FC + ch * 16) = w; }
        __syncthreads();
        LAS bf16* c0 = (LAS bf16*)FC;
        for (int task = tid; task < 7 * ((2 * L + 16) / 8); task += 512) { const int r = 1 + task / ((2 * L + 16) / 8), y8 = (task % ((2 * L + 16) / 8)) * 8; unsigned e[8];
#pragma unroll
            for (int jj = 0; jj < 8; ++jj) { const int y = y8 - r + jj; e[jj] = (y >= 0) ? (unsigned)c0[y] : 0u; }
            u32x4 w; w.x = e[0] | (e[1] << 16); w.y = e[2] | (e[3] << 16); w.z = e[4] | (e[5] << 16); w.w = e[6] | (e[7] << 16);
            *(LAS u32x4*)(FC + r * CS + y8 * 2) = w; }
    };
    for (int i = tid; i < 16 * 32; i += 512) { const int pc = i >> 5, q = i & 31; const int col = (pc < 8) ? pc : NCOL + pc; *(LAS unsigned*)(ZB + col * ZS + q * 4) = 0u; }
    load_stream(0, ZB, 8);
    load_stream(1, XB, 0);
    f32x4 acc[4][NN];
#pragma unroll
    for (int o = 0; o < 2; ++o) {
        load_filter(o);
        __syncthreads();
#pragma unroll
        for (int mi = 0; mi < 4; ++mi)
#pragma unroll
            for (int nn = 0; nn < NN; ++nn) acc[mi][nn] = (f32x4){0.f, 0.f, 0.f, 0.f};
        for (int db = -(NTAU - 1); db <= NTAU - 1; ++db) {
            bool val[NN]; bool any = false;
#pragma unroll
            for (int nn = 0; nn < NN; ++nn) { const int sc0 = 16 * (wave * NN + nn) - NBt * db; val[nn] = (sc0 + 15 >= 0) && (sc0 < NCOL); any |= val[nn]; }
            if (!any) continue;
            bf16x8 af[4][2];
#pragma unroll
            for (int mi = 0; mi < 4; ++mi)
#pragma unroll
                for (int ks = 0; ks < 2; ++ks) { const int y = L - 64 * db - 16 * mi - 8 * (i16 >> 3) + 32 * ks + 8 * kg; af[mi][ks] = *(const LAS bf16x8*)(FC + (i16 & 7) * CS + y * 2); }
#pragma unroll
            for (int nn = 0; nn < NN; ++nn) {
                if (!val[nn]) continue;
                const int col = 16 * (wave * NN + nn) + i16 - NBt * db + 8;
#pragma unroll
                for (int ks = 0; ks < 2; ++ks) { const bf16x8 bfr = *(const LAS bf16x8*)(ZB + col * ZS + (32 * ks + 8 * kg) * 2);
#pragma unroll
                    for (int mi = 0; mi < 4; ++mi) acc[mi][nn] = __builtin_amdgcn_mfma_f32_16x16x32_bf16(af[mi][ks], bfr, acc[mi][nn], 0, 0, 0); }
            }
        }
        __syncthreads();
        const float bias = C.in[I_HBIAS][((size_t)layer * 2 + o) * 512 + c];
#pragma unroll
        for (int nn = 0; nn < NN; ++nn) {
            const int col = 16 * (wave * NN + nn) + i16;
#pragma unroll
            for (int mi = 0; mi < 4; ++mi) { const int i0 = 16 * mi + 4 * kg;
                LAS u32x2* zp = (LAS u32x2*)(ZB + (col + 8) * ZS + i0 * 2); const u32x2 zv = *zp, xv = *(const LAS u32x2*)(XB + col * ZS + i0 * 2);
                const float z0 = bflo(zv.x), z1 = bfhi(zv.x), z2 = bflo(zv.y), z3 = bfhi(zv.y);
                const float r0 = bflo(xv.x) * (acc[mi][nn][0] + bias * z0), r1 = bfhi(xv.x) * (acc[mi][nn][1] + bias * z1), r2 = bflo(xv.y) * (acc[mi][nn][2] + bias * z2), r3 = bfhi(xv.y) * (acc[mi][nn][3] + bias * z3);
                u32x2 w; w.x = pk2(r0, r1); w.y = pk2(r2, r3);
                if (o == 0) *zp = w;
                else { const int tau = col / NBt, b = col % NBt; *(u32x2*)(hyo + (size_t)c * M + row_base + b * L + 64 * tau + i0) = w; } }
        }
        if (o == 0) { __syncthreads(); load_stream(2, XB, 0); }
    }
}

__device__ __forceinline__ void fin_phase(const Ctx& C, int layer) {
    const float* of = (const float*)(C.ws + WS_OF); const float* ob = (const float*)(C.ws + WS_OB); const float* bs = (const float*)(C.ws + WS_BS);
    const bf16* rkvg = (const bf16*)(C.ws + WS_RKVG); bf16* mix = (bf16*)(C.ws + WS_MIX);
    const int lane = C.lane;
    { const int hq = lane >> 4, c4 = (lane & 15) * 4;
    for (int task = C.bid * 8 + C.wave; task < M * 3; task += C.G * 8) {
        const int token = task / 3, h = (task % 3) * 4 + hq; const size_t oi = (size_t)token * RW + h * 64 + c4;
#if DBG_SKIP_RWKV
        *(u32x2*)(mix + (size_t)token * D + h * 64 + c4) = (u32x2){0u, 0u};
#else
        const f32x4 o = *(const f32x4*)(of + oi) + *(const f32x4*)(ob + oi);
        const float mu = row16_sum((o[0] + o[1]) + (o[2] + o[3])) * (1.0f / 64.0f);
        const f32x4 dd = o - mu;
        const float var = row16_sum((dd[0] * dd[0] + dd[1] * dd[1]) + (dd[2] * dd[2] + dd[3] * dd[3])) * (1.0f / 64.0f);
        const f32x4 lg = *(const f32x4*)(C.in[I_LNXG] + layer * RW + h * 64 + c4), lb = *(const f32x4*)(C.in[I_LNXB] + layer * RW + h * 64 + c4);
        const f32x4 on = dd * (lg * rsqrtf(var + GN_EPS)) + lb;
        const float bon = bs[(size_t)h * M + token] + bs[(size_t)(RH + h) * M + token];
        const u32x2 vw = *(const u32x2*)(rkvg + (size_t)token * 3072 + 1536 + h * 64 + c4), gw = *(const u32x2*)(rkvg + (size_t)token * 3072 + 2304 + h * 64 + c4);
        const float r0 = (on[0] + bon * bflo(vw.x)) * __builtin_amdgcn_rcpf(1.0f + __expf(-bflo(gw.x))), r1 = (on[1] + bon * bfhi(vw.x)) * __builtin_amdgcn_rcpf(1.0f + __expf(-bfhi(gw.x)));
        const float r2 = (on[2] + bon * bflo(vw.y)) * __builtin_amdgcn_rcpf(1.0f + __expf(-bflo(gw.y))), r3 = (on[3] + bon * bfhi(vw.y)) * __builtin_amdgcn_rcpf(1.0f + __expf(-bfhi(gw.y)));
        u32x2 w; w.x = pk2(r0, r1); w.y = pk2(r2, r3);
        *(u32x2*)(mix + (size_t)token * D + h * 64 + c4) = w;
#endif
    } }
    const bf16* hyo = (const bf16*)(C.ws + WS_HYO);
    LAS bf16* tile = (LAS bf16*)C.lds;
    for (int job = C.bid; job < 8 * (M / 64); job += C.G) {
        const int ct = job / (M / 64), tt = job % (M / 64), c0 = ct * 64, tok0 = tt * 64;
        __syncthreads();
        { const int c = C.tid >> 3, t8 = (C.tid & 7) * 8;
#if DBG_SKIP_HYENA
          const u32x4 w = (u32x4){0u, 0u, 0u, 0u};
#else
          const u32x4 w = *(const u32x4*)(hyo + (size_t)(c0 + c) * M + tok0 + t8);
#endif
          *(LAS u32x4*)(tile + c * 72 + t8) = w; }
        __syncthreads();
        { const int tok = C.tid >> 3, c8 = (C.tid & 7) * 8; unsigned e[8];
#pragma unroll
          for (int j = 0; j < 8; ++j) e[j] = tile[(c8 + j) * 72 + tok];
          u32x4 w; w.x = e[0] | (e[1] << 16); w.y = e[2] | (e[3] << 16); w.z = e[4] | (e[5] << 16); w.w = e[6] | (e[7] << 16);
          *(u32x4*)(mix + (size_t)(tok0 + tok) * D + 768 + c0 + c8) = w; }
    }
}

constexpr int S2_PT = 0, S2_RT = 2048, S2_QT = 4096, S2_KT = 6144, S2_QK = 8192, S2_VM = 12288, S2_A2T = 14336, S2_A34 = 14848, S2_TT = 15872, S2_GC = 16384, S2_A1F = 16640, S2_BON = 17664, S2_SLOT = 19712;
__device__ __forceinline__ float fast_sigmoid(float x) { return __builtin_amdgcn_rcpf(1.0f + __expf(-x)); }
__device__ __forceinline__ float wave64_sum(float x) { x = row16_sum(x); const int xi = __float_as_int(x);
    const float a = __int_as_float(__builtin_amdgcn_readlane(xi, 0)), b = __int_as_float(__builtin_amdgcn_readlane(xi, 16)), c = __int_as_float(__builtin_amdgcn_readlane(xi, 32)), d = __int_as_float(__builtin_amdgcn_readlane(xi, 48));
    return (a + b) + (c + d); }
__device__ __forceinline__ s16x4 pack4(const f32x4& v) { u32x2 w; w.x = pk2(v[0], v[1]); w.y = pk2(v[2], v[3]); return __builtin_bit_cast(s16x4, w); }
__device__ __forceinline__ bf16x8 pack8(const f32x4& a, const f32x4& b) { u32x4 w; w.x = pk2(a[0], a[1]); w.y = pk2(a[2], a[3]); w.z = pk2(b[0], b[1]); w.w = pk2(b[2], b[3]); return __builtin_bit_cast(bf16x8, w); }
__device__ __forceinline__ bf16x8 cat8(const s16x4& a, const s16x4& b) { bf16x8 r; r[0] = a[0]; r[1] = a[1]; r[2] = a[2]; r[3] = a[3]; r[4] = b[0]; r[5] = b[1]; r[6] = b[2]; r[7] = b[3]; return r; }

__device__ __forceinline__ void kknorm_phase(const Ctx& C, int layer) {
    const bf16* rkvg = (const bf16*)(C.ws + WS_RKVG); float* inv = (float*)(C.ws + WS_INV);
    for (int task = C.bid * 512 + C.tid; task < M * RH; task += C.G * 512) {
        const int token = task / RH, h = task % RH;
        const bf16* kp = rkvg + (size_t)token * 3072 + 768 + h * 64; const float* pk = C.in[I_KK] + layer * RW + h * 64;
        float ss = 0.f;
#pragma unroll
        for (int q = 0; q < 8; ++q) { const u32x4 a = *(const u32x4*)(kp + 8 * q); const f32x4 p0 = *(const f32x4*)(pk + 8 * q), p1 = *(const f32x4*)(pk + 8 * q + 4);
            const float x0 = bflo(a[0]) * p0[0], x1 = bfhi(a[0]) * p0[1], x2 = bflo(a[1]) * p0[2], x3 = bfhi(a[1]) * p0[3], x4 = bflo(a[2]) * p1[0], x5 = bfhi(a[2]) * p1[1], x6 = bflo(a[3]) * p1[2], x7 = bfhi(a[3]) * p1[3];
            ss += (x0 * x0 + x1 * x1) + (x2 * x2 + x3 * x3) + (x4 * x4 + x5 * x5) + (x6 * x6 + x7 * x7); }
        inv[task] = __builtin_amdgcn_rsqf(fmaxf(ss, 1e-24f));
    }
}

__device__ __forceinline__ void scan2_item(const Ctx& C, int layer, int item) {
    const int latent = item < 192; const int it2 = latent ? item : item - 192;
    const int b = it2 / 24, h = (it2 % 24) >> 1, d = it2 & 1;
    const int T = latent ? T_D : T_C, row_base = latent ? MC + b * T_D : b * T_C, nch = T / 16;
    const bf16* rkvg = (const bf16*)(C.ws + WS_RKVG); const bf16* lw = (const bf16*)(C.ws + WS_LW);
    float* obase = (float*)(C.ws + (d ? WS_OB : WS_OF)); float* bs = (float*)(C.ws + WS_BS); const float* invn = (const float*)(C.ws + WS_INV);
    const int lane = C.lane, wave = C.wave, c16 = lane & 15, quad = lane >> 4;
    __syncthreads();
    if (wave == 0) {
        f32x4 S[4][4];
        const size_t soff = ((((size_t)b * DEPTH + layer) * 2 + d) * RH + h) * 4096;
#pragma unroll
        for (int kt = 0; kt < 4; ++kt)
#pragma unroll
            for (int vt = 0; vt < 4; ++vt) S[kt][vt] = latent ? *(const f32x4*)(C.in[I_STATE] + soff + (16 * vt + c16) * 64 + 16 * kt + 4 * quad) : (f32x4){0.f, 0.f, 0.f, 0.f};
        for (int it = -6; it < nch; ++it) {
            if (it >= 0) {
                const LAS unsigned char* sl = C.lds + (it % 7) * S2_SLOT;
                bf16x8 sf[2][4];
#pragma unroll
                for (int ks = 0; ks < 2; ++ks)
#pragma unroll
                    for (int vt = 0; vt < 4; ++vt) sf[ks][vt] = pack8(S[2 * ks][vt], S[2 * ks + 1][vt]);
                const bf16x8 pt0 = *(const LAS bf16x8*)(sl + S2_PT + lane * 16), pt1 = *(const LAS bf16x8*)(sl + S2_PT + (64 + lane) * 16);
                const bf16x8 rt0 = *(const LAS bf16x8*)(sl + S2_RT + lane * 16), rt1 = *(const LAS bf16x8*)(sl + S2_RT + (64 + lane) * 16);
                const s16x4 a2t = *(const LAS s16x4*)(sl + S2_A2T + lane * 8), tt = *(const LAS s16x4*)(sl + S2_TT + lane * 8);
                const bf16x8 a34 = *(const LAS bf16x8*)(sl + S2_A34 + lane * 16);
                f32x4 O[4]; bf16x8 uv[4]; const s16x4 z4 = (s16x4){0, 0, 0, 0};
#pragma unroll
                for (int vt = 0; vt < 4; ++vt) {
                    const s16x4 vm = *(const LAS s16x4*)(sl + S2_VM + (vt * 64 + lane) * 8);
                    f32x4 w = (f32x4){0.f, 0.f, 0.f, 0.f}, o = w;
                    w = __builtin_amdgcn_mfma_f32_16x16x32_bf16(pt0, sf[0][vt], w, 0, 0, 0);
                    w = __builtin_amdgcn_mfma_f32_16x16x32_bf16(pt1, sf[1][vt], w, 0, 0, 0);
                    w = __builtin_amdgcn_mfma_f32_16x16x32_bf16(cat8(a2t, z4), cat8(vm, z4), w, 0, 0, 0);
                    o = __builtin_amdgcn_mfma_f32_16x16x32_bf16(rt0, sf[0][vt], o, 0, 0, 0);
                    o = __builtin_amdgcn_mfma_f32_16x16x32_bf16(rt1, sf[1][vt], o, 0, 0, 0);
                    f32x4 u = (f32x4){0.f, 0.f, 0.f, 0.f};
                    u = __builtin_amdgcn_mfma_f32_16x16x32_bf16(cat8(tt, z4), cat8(pack4(w), z4), u, 0, 0, 0);
                    uv[vt] = cat8(pack4(u), vm);
                    O[vt] = __builtin_amdgcn_mfma_f32_16x16x32_bf16(a34, uv[vt], o, 0, 0, 0);
                }
#pragma unroll
                for (int kt = 0; kt < 4; ++kt) {
                    const bf16x8 qk = *(const LAS bf16x8*)(sl + S2_QK + (kt * 64 + lane) * 16);
                    const f32x4 g4 = *(const LAS f32x4*)(sl + S2_GC + (16 * kt + 4 * quad) * 4);
#pragma unroll
                    for (int vt = 0; vt < 4; ++vt) S[kt][vt] = __builtin_amdgcn_mfma_f32_16x16x32_bf16(qk, uv[vt], S[kt][vt], 0, 0, 0) * g4;
                }
#pragma unroll
                for (int rg = 0; rg < 4; ++rg) { const int step = it * 16 + 4 * quad + rg, t = d ? (T - 1 - step) : step; float* op = obase + (size_t)(row_base + t) * RW + h * 64 + c16;
#pragma unroll
                    for (int vt = 0; vt < 4; ++vt) op[16 * vt] = O[vt][rg]; }
            }
            __syncthreads();
        }
        if (!latent) {
#pragma unroll
            for (int kt = 0; kt < 4; ++kt)
#pragma unroll
                for (int vt = 0; vt < 4; ++vt) *(f32x4*)(C.out + O_STATE + soff + (16 * vt + c16) * 64 + 16 * kt + 4 * quad) = S[kt][vt];
        }
    } else {
        const int j = wave - 1, k = lane, pc = h * 64 + k;
        LAS unsigned char* sl = C.lds + j * S2_SLOT;
        const float pw0 = C.in[I_W0][(layer * 2 + d) * RW + pc], pa0 = C.in[I_A0][(layer * 2 + d) * RW + pc];
        const float pkk = C.in[I_KK][layer * RW + pc], pka = C.in[I_KA][layer * RW + pc], prk = C.in[I_RK][layer * RW + pc];
        const int ks_ = k >> 5, kk5 = k & 31, tl_lane = ((kk5 >> 2) & 3) * 16, tl_j = ((kk5 >> 4) << 2) | (kk5 & 3);
        const int qk_base = ((k >> 4) * 64 + (k & 15)) * 8;
        const int vm_base = ((k >> 4) * 64 + (k & 15)) * 4;
        float L = 0.f, Gprev = 1.f;
        unsigned short xr[4], xk[4], xv[4], xw[4], xa[4]; float xi[4];
#pragma unroll
        for (int ii = 0; ii < 4; ++ii) { xr[ii] = 0; xk[ii] = 0; xv[ii] = 0; xw[ii] = 0; xa[ii] = 0; xi[ii] = 0.f; }
        auto issue = [&](int itn) {
            int phn = (itn + 6 - j) % 7; if (phn < 0) phn += 7;
            const int cn = itn + 6 - phn;
            if (phn < 4 && cn >= 0 && cn < nch) {
#pragma unroll
                for (int ii = 0; ii < 4; ++ii) { const int step = cn * 16 + phn * 4 + ii, t = d ? (T - 1 - step) : step; const size_t row = (size_t)(row_base + t);
                    const bf16* rp = rkvg + row * 3072 + pc; xr[ii] = rp[0]; xk[ii] = rp[768]; xv[ii] = rp[1536];
                    const bf16* lp = lw + row * 3072 + d * 768 + pc; xw[ii] = lp[0]; xa[ii] = lp[1536]; xi[ii] = invn[row * RH + h]; }
            }
        };
        issue(-6);
        for (int it = -6; it < nch; ++it) {
            int ph = (it + 6 - j) % 7; if (ph < 0) ph += 7;
            const int c = it + 6 - ph;
            if (ph < 6 && c >= 0 && c < nch) {
                if (ph < 4) {
                    if (ph == 0) { L = 0.f; Gprev = 1.f; }
                    unsigned short yr[4], yk[4], yv[4], yw[4], ya[4]; float yi[4];
#pragma unroll
                    for (int ii = 0; ii < 4; ++ii) { yr[ii] = xr[ii]; yk[ii] = xk[ii]; yv[ii] = xv[ii]; yw[ii] = xw[ii]; ya[ii] = xa[ii]; yi[ii] = xi[ii]; }
                    issue(it + 1);
#pragma unroll
                    for (int ii = 0; ii < 4; ++ii) {
                        const int i = ph * 4 + ii, step = c * 16 + i, t = d ? (T - 1 - step) : step;
                        const float r = bf2f(yr[ii]), kx = bf2f(yk[ii]);
                        const float kk = kx * pkk * yi[ii];
                        const float e = 0.6065306597126334f * fast_sigmoid(pw0 + bf2f(yw[ii]));
                        L -= e;
                        const float Gp = Gprev, G = __expf(L), Gi = __builtin_amdgcn_rcpf(G); Gprev = G;
                        const float a = fast_sigmoid(pa0 + bf2f(ya[ii]));
                        const float q = kk * a, kd = kx * (1.0f + (a - 1.0f) * pka);
                        ((LAS bf16*)(sl + S2_BON))[i * 64 + k] = (bf16)f2bf(r * kd * prk);
                        const int ti = (ks_ * 64 + tl_lane + i) * 8 + tl_j;
                        const unsigned pr = pk2(-kk * Gp, r * G), qkp = pk2(q * Gi, kd * Gi);
                        ((LAS bf16*)(sl + S2_PT))[ti] = (bf16)pr;
                        ((LAS bf16*)(sl + S2_RT))[ti] = (bf16)(pr >> 16);
                        const unsigned qb = qkp & 0xffffu, kb = qkp >> 16;
                        ((LAS bf16*)(sl + S2_QT))[ti] = (bf16)qb;
                        ((LAS bf16*)(sl + S2_KT))[ti] = (bf16)kb;
                        const int qi = qk_base + (i >> 2) * 128 + (i & 3);
                        ((LAS bf16*)(sl + S2_QK))[qi] = (bf16)qb; ((LAS bf16*)(sl + S2_QK))[qi + 4] = (bf16)kb;
                        ((LAS bf16*)(sl + S2_VM))[vm_base + (i >> 2) * 64 + (i & 3)] = yv[ii];
                        if (i == 15) ((LAS float*)(sl + S2_GC))[k] = G;
                    }
                } else if (ph == 4) {
                    issue(it + 1);
                    { const int sb = lane >> 2, g = lane & 3; const u32x4 b0 = *(const LAS u32x4*)(sl + S2_BON + (sb * 64 + g * 16) * 2), b1 = *(const LAS u32x4*)(sl + S2_BON + (sb * 64 + g * 16 + 8) * 2);
                      float bsum = ((bflo(b0[0]) + bfhi(b0[0])) + (bflo(b0[1]) + bfhi(b0[1]))) + ((bflo(b0[2]) + bfhi(b0[2])) + (bflo(b0[3]) + bfhi(b0[3])));
                      bsum += ((bflo(b1[0]) + bfhi(b1[0])) + (bflo(b1[1]) + bfhi(b1[1]))) + ((bflo(b1[2]) + bfhi(b1[2])) + (bflo(b1[3]) + bfhi(b1[3])));
                      bsum += dpp_f<0xB1>(bsum); bsum += dpp_f<0x4E>(bsum);
                      if (g == 0) { const int step = c * 16 + sb, t = d ? (T - 1 - step) : step; bs[(size_t)(d * RH + h) * M + (row_base + t)] = bsum; } }
                    f32x4 a1 = (f32x4){0.f, 0.f, 0.f, 0.f}, a2 = a1, a3 = a1, a4 = a1;
#pragma unroll
                    for (int ks = 0; ks < 2; ++ks) {
                        const bf16x8 fq = *(const LAS bf16x8*)(sl + S2_QT + (ks * 64 + lane) * 16), fk = *(const LAS bf16x8*)(sl + S2_KT + (ks * 64 + lane) * 16);
                        const bf16x8 fp = *(const LAS bf16x8*)(sl + S2_PT + (ks * 64 + lane) * 16), fr = *(const LAS bf16x8*)(sl + S2_RT + (ks * 64 + lane) * 16);
                        a1 = __builtin_amdgcn_mfma_f32_16x16x32_bf16(fq, fp, a1, 0, 0, 0); a2 = __builtin_amdgcn_mfma_f32_16x16x32_bf16(fk, fp, a2, 0, 0, 0);
                        a3 = __builtin_amdgcn_mfma_f32_16x16x32_bf16(fq, fr, a3, 0, 0, 0); a4 = __builtin_amdgcn_mfma_f32_16x16x32_bf16(fk, fr, a4, 0, 0, 0);
                    }
#pragma unroll
                    for (int rg = 0; rg < 4; ++rg) { const int s = 4 * quad + rg; const bool lt = s < c16, le = s <= c16;
                        a1[rg] = lt ? a1[rg] : 0.f; a2[rg] = lt ? a2[rg] : 0.f; a3[rg] = le ? a3[rg] : 0.f; a4[rg] = le ? a4[rg] : 0.f;
                    }
                    *(LAS f32x4*)(sl + S2_A1F + (c16 * 16 + 4 * quad) * 4) = a1;
                    *(LAS s16x4*)(sl + S2_A2T + lane * 8) = pack4(a2);
                    *(LAS bf16x8*)(sl + S2_A34 + lane * 16) = pack8(a3, a4);
                } else {
                    issue(it + 1);
                    float tr[16];
#pragma unroll
                    for (int tb = 0; tb < 4; ++tb) {
                        f32x4 col[4][4];
#pragma unroll
                        for (int t4 = 0; t4 < 4; ++t4)
#pragma unroll
                            for (int q = 0; q <= tb; ++q) col[t4][q] = *(const LAS f32x4*)(sl + S2_A1F + ((4 * tb + t4) * 16 + 4 * q) * 4);
#pragma unroll
                        for (int t4 = 0; t4 < 4; ++t4) { const int t = 4 * tb + t4; float acc = (lane == t) ? 1.0f : 0.f;
#pragma unroll
                            for (int jj = 0; jj < t; ++jj) acc += tr[jj] * col[t4][jj >> 2][jj & 3];
                            tr[t] = acc; }
                    }
                    if (lane < 16) {
#pragma unroll
                        for (int t = 0; t < 16; ++t) ((LAS bf16*)(sl + S2_TT))[((lane >> 2) * 16 + t) * 4 + (lane & 3)] = (bf16)f2bf(tr[t]); }
                }
            } else issue(it + 1);
            __syncthreads();
        }
    }
}


__global__ void __launch_bounds__(512, 2) mega_fwd(Params P) {
    extern __shared__ __attribute__((aligned(16))) unsigned char lds_raw[];
#define MKCTX() Ctx C; { int tid_ = threadIdx.x; asm volatile("" : "+v"(tid_)); int z_ = 0; asm volatile("" : "+s"(z_)); \
    C.lds = (LAS unsigned char*)lds_raw + z_; C.tid = tid_; C.lane = tid_ & 63; C.wave = __builtin_amdgcn_readfirstlane(tid_ >> 6); C.G = gridDim.x; C.bid = blockIdx.x; \
    C.in = P.in + z_; C.out = P.out + z_; C.ws = P.ws + z_; C.ctl = (unsigned*)(P.ws + WS_CTL) + z_; } \
    unsigned char* ws = C.ws; const float* modall = (const float*)(ws + WS_MOD); float* Y = C.out + O_Y; float* X1 = (float*)(ws + WS_X1); bf16* Hb = (bf16*)(ws + WS_H); const float* modl = modall + (size_t)l * 9 * NMOD; \
    (void)Y; (void)X1; (void)Hb; (void)modl;
    volatile LAS unsigned* misc = (volatile LAS unsigned*)((LAS unsigned char*)lds_raw + LDS_MISC);
    if (threadIdx.x < 64) misc[threadIdx.x] = 0u;
    __syncthreads();
    (void)xcd_barrier_post((unsigned*)(P.ws + WS_CTL) + CW_BAR, misc);
#define GRID_BAR() do { XcdBarrier b_; { int zb_ = 0; asm volatile("" : "+s"(zb_)); b_.bar = (unsigned*)(P.ws + WS_CTL) + CW_BAR + zb_; } b_.x = xb_xcc_id(); b_.st = misc; xcd_barrier(b_); } while (0)

    { const int l = 0; { MKCTX(); for (int rep_ = 0; rep_ < REP_P0; ++rep_) p0_transposes(C); } { MKCTX(); p0_wl2(C); } { MKCTX(); for (int rep_ = 0; rep_ < REP_P0; ++rep_) p0_mod(C); } { MKCTX(); for (int rep_ = 0; rep_ < REP_P0; ++rep_) p0_filters(C); } { MKCTX(); p0_rope(C); }
      GRID_BAR();
      { MKCTX(); p0_h0(C); }
      GRID_BAR(); }

    for (int l = 0; l < DEPTH; ++l) {
        { MKCTX();
            pg8::Gemm g{Hb, (const bf16*)(ws + WS_WIN) + (size_t)l * N1 * D, M, N1, D}; pg8::StaticOrder S; S.init(M, N1, C.G, C.bid);
            pg8::Epi1 E{(bf16*)(ws + WS_RKVG), (bf16*)(ws + WS_QKV), (bf16*)(ws + WS_LH), (bf16*)(ws + WS_HYT), C.out + O_CK, C.out + O_CV, l, M};
            for (int rep_ = 0; rep_ < REP_GEMM; ++rep_) pg8::gemm_phase<pg8::Epi1, pg8::StaticOrder, false, true>(C.lds, g, S, E);
        }
        GRID_BAR();
        { MKCTX(); kknorm_phase(C, l); }
        { MKCTX();
            pg8::Gemm g{(const bf16*)(ws + WS_LH), (const bf16*)(ws + WS_WL2) + (size_t)l * 3072 * 256, M, 3072, 256}; pg8::StaticOrder S; S.init(M, 3072, C.G, C.bid);
            pg8::EpiPlain E{(bf16*)(ws + WS_LW), 3072};
            for (int rep_ = 0; rep_ < REP_GEMM; ++rep_) pg8::gemm_phase<pg8::EpiPlain, pg8::StaticOrder, false, true>(C.lds, g, S, E);
        }
        { MKCTX();
        for (;;) {
            const int it = queue_pop(C, l * 2 + 0);
            if (it >= 256 + 512 + 512 + 128) break;
            if (it < 256) {
#if !DBG_SKIP_ATTN
                for (int rep_ = 0; rep_ < REP_ATT; ++rep_) { const Ctx Ci = relaunder(C); attn_item3(Ci, l, true, it >> 5, (it >> 3) & 3, it & 7); }
#endif
            } else if (it < 768) {
#if !DBG_SKIP_HYENA
                for (int rep_ = 0; rep_ < REP_HY; ++rep_) { const Ctx Ci = relaunder(C); hyena_item<0>(Ci, l, it - 256); }
#endif
            } else if (it < 1280) {
#if !DBG_SKIP_HYENA
                for (int rep_ = 0; rep_ < REP_HY; ++rep_) { const Ctx Ci = relaunder(C); hyena_item<1>(Ci, l, it - 768); }
#endif
            } else { const int a = it - 1280;
#if !DBG_SKIP_ATTN
                for (int rep_ = 0; rep_ < REP_ATT; ++rep_) { const Ctx Ci = relaunder(C); attn_item3(Ci, l, false, a >> 2, a & 3, 0); }
#endif
            }
        } }
        GRID_BAR();
#if !DBG_SKIP_RWKV
        { MKCTX(); for (;;) { const int it = queue_pop(C, l * 2 + 1); if (it >= 960) break; for (int rep_ = 0; rep_ < REP_SCAN; ++rep_) scan2_item(C, l, it); } }
#endif
        GRID_BAR();
        { MKCTX(); for (int rep_ = 0; rep_ < REP_FIN; ++rep_) fin_phase(C, l);
#if DBG_SKIP_ATTN
        { bf16* mix = (bf16*)(ws + WS_MIX); for (int i = C.bid * 512 + C.tid; i < M * 96; i += C.G * 512) { const int row = i / 96, c8 = (i % 96) * 8; *(u32x4*)(mix + (size_t)row * D + 1280 + c8) = (u32x4){0u, 0u, 0u, 0u}; } }
#endif
        }
        GRID_BAR();
        { MKCTX();
            pg8::Gemm g{(const bf16*)(ws + WS_MIX), (const bf16*)(ws + WS_WOUT) + (size_t)l * D * D, M, D, D}; pg8::StaticOrder S; S.init(M, D, C.G, C.bid);
            pg8::EpiRes E{(l == 0) ? C.in[I_XP] : Y, (l == 0) ? C.in[I_XS] : Y, (l == 0) ? MC : M, modl + 2 * D, NMOD, X1, D, DN_ALPHA};
            for (int rep_ = 0; rep_ < REP_GEMM; ++rep_) pg8::gemm_phase<pg8::EpiRes, pg8::StaticOrder, false, true>(C.lds, g, S, E);
        }
        GRID_BAR();
        { MKCTX(); ln_phase(C, X1, C.in[I_LN1G] + l * D, C.in[I_LN1B] + l * D, modl, 3 * D, 4 * D, Hb); }
        GRID_BAR();
#if !DBG_SKIP_FFN
        { MKCTX();
            pg8::Gemm g{Hb, (const bf16*)(ws + WS_WUP) + (size_t)l * NUP * D, M, NUP, D}; pg8::StaticOrder S; S.init(M, NUP, C.G, C.bid);
            pg8::EpiGate E{(bf16*)(ws + WS_G), C.in[I_CONVW] + (size_t)l * 3 * NUP, (float*)(ws + WS_HALO), C.lds + 131072};
            for (int rep_ = 0; rep_ < REP_GEMM; ++rep_) pg8::gemm_phase<pg8::EpiGate, pg8::StaticOrder, true, true>(C.lds, g, S, E);
        }
        GRID_BAR();
        { MKCTX(); gate_fixup_phase(C, (const float*)(ws + WS_HALO), C.in[I_CONVW] + (size_t)l * 3 * NUP, (bf16*)(ws + WS_G)); }
        GRID_BAR();
#endif
        { MKCTX();
            pg8::Gemm g{(const bf16*)(ws + WS_G), (const bf16*)(ws + WS_WDN) + (size_t)l * D * DFF, M, D, DFF}; pg8::StaticOrder S; S.init(M, D, C.G, C.bid);
            pg8::EpiRes E{X1, X1, M, modl + 5 * D, NMOD, Y, D, DN_ALPHA};
            for (int rep_ = 0; rep_ < REP_GEMM; ++rep_) pg8::gemm_phase<pg8::EpiRes, pg8::StaticOrder, false, true>(C.lds, g, S, E);
        }
        GRID_BAR();
        { MKCTX(); ln_phase(C, Y, C.in[I_LN2G] + l * D, C.in[I_LN2B] + l * D, (l + 1 < DEPTH) ? modl + 9 * NMOD : nullptr, 0, D, Hb); }
        if (l + 1 < DEPTH) GRID_BAR();
    }
}

extern "C" void kernel_launch(void* const* d_in, const int* in_sizes, int n_in, void* d_out, int out_size, void* d_ws, size_t ws_size, hipStream_t stream) {
    static int grid = 0;
    if (grid == 0) {
        if (n_in != N_IN || ws_size < WS_END) { fprintf(stderr, "kernel_launch: unexpected n_in %d or ws_size %zu (< %zu)\n", n_in, ws_size, (size_t)WS_END); grid = -1; return; }
        int dev = 0, cus = 0, per_cu = 0;
        if (hipGetDevice(&dev) != hipSuccess || hipDeviceGetAttribute(&cus, hipDeviceAttributeMultiprocessorCount, dev) != hipSuccess) { grid = -1; return; }
        if (hipFuncSetAttribute((const void*)mega_fwd, hipFuncAttributeMaxDynamicSharedMemorySize, LDS_BYTES) != hipSuccess) { fprintf(stderr, "kernel_launch: hipFuncSetAttribute failed\n"); grid = -1; return; }
        if (hipOccupancyMaxActiveBlocksPerMultiprocessor(&per_cu, (const void*)mega_fwd, 512, LDS_BYTES) != hipSuccess || per_cu < 1) { fprintf(stderr, "kernel_launch: occupancy query says %d\n", per_cu); }
        (void)hipGetLastError();
        grid = cus;
    }
    if (grid < 0) return;
    (void)hipMemsetAsync((char*)d_ws + WS_CTL, 0, 1 * MiB, stream);
    Params p{};
    for (int i = 0; i < N_IN; ++i) p.in[i] = (const float*)d_in[i];
    p.out = (float*)d_out; p.ws = (unsigned char*)d_ws;
    hipLaunchKernelGGL(mega_fwd, dim3(grid), dim3(512), LDS_BYTES, stream, p);
}
```

```cpp
#include <hip/hip_runtime.h>
#include <cstdio>
#include <cstdint>

#ifndef DBG_SKIP_RWKV
#define DBG_SKIP_RWKV 0
#endif
#ifndef DBG_SKIP_HYENA
#define DBG_SKIP_HYENA 0
#endif
#ifndef DBG_SKIP_ATTN
#define DBG_SKIP_ATTN 0
#endif
#ifndef DBG_SKIP_FFN
#define DBG_SKIP_FFN 0
#endif

#ifndef REP_GEMM
#define REP_GEMM 1
#endif
#ifndef REP_SCAN
#define REP_SCAN 1
#endif
#ifndef REP_HY
#define REP_HY 1
#endif
#ifndef REP_ATT
#define REP_ATT 1
#endif
#ifndef REP_FIN
#define REP_FIN 1
#endif
#ifndef REP_CG
#define REP_CG 1
#endif
#ifndef REP_P0
#define REP_P0 1
#endif
#define LAS __attribute__((address_space(3)))
typedef unsigned short bf16;
typedef short bf16x8 __attribute__((ext_vector_type(8)));
typedef short s16x4 __attribute__((ext_vector_type(4)));
typedef float f32x4 __attribute__((ext_vector_type(4)));
typedef float f32x2 __attribute__((ext_vector_type(2)));
typedef float f32x16 __attribute__((ext_vector_type(16)));
typedef unsigned u32x4 __attribute__((ext_vector_type(4)));
typedef unsigned u32x2 __attribute__((ext_vector_type(2)));
typedef __bf16 hwbf16x2 __attribute__((ext_vector_type(2)));

constexpr int D = 2048, NB_C = 32, T_C = 256, NB_D = 8, T_D = 2048, DEPTH = 4, PAST = 512;
constexpr int MC = NB_C * T_C, MD = NB_D * T_D, M = MC + MD;
constexpr int RW = 768, RH = 12, HD = 64, HW = 512, AW = 768, AH = 12, KVH = 4, KVW = 256;
constexpr int INW = 5888, N1 = 6144, DFF = 5504, NUP = 11008, NMOD = 12288;
constexpr int NQKV = 1280;
constexpr float LN_EPS = 1e-5f, GN_EPS = 64e-5f;
constexpr float DN_ALPHA = 1.681792830507429f;
enum { I_XP = 0, I_XS, I_C, I_STATE, I_CK, I_CV, I_CCTX, I_WMOD, I_BMOD, I_WIN, I_W0, I_W1, I_W2, I_A0, I_A1, I_A2, I_KK, I_KA, I_RK, I_LNXG, I_LNXB,
       I_HSW, I_FW1, I_FB1, I_FF1, I_FW2, I_FB2, I_FF2, I_FW3, I_HBIAS, I_SINK, I_WOUT, I_LN1G, I_LN1B, I_WUP, I_CONVW, I_WDN, I_LN2G, I_LN2B, N_IN };
constexpr size_t O_Y = 0, O_STATE = (size_t)M * D, O_CK = O_STATE + (size_t)NB_C * DEPTH * 2 * RH * 64 * 64, O_CV = O_CK + (size_t)NB_C * DEPTH * T_C * KVW;

constexpr size_t MiB = 1u << 20;
constexpr size_t WS_CTL = 0;
constexpr size_t WS_MOD = 1 * MiB;
constexpr size_t WS_ROPE = 3 * MiB;
constexpr size_t WS_FILT = 4 * MiB;
constexpr size_t FILT_LAYER = 9 * MiB, FILT_CTX_OFF = 8 * MiB;
constexpr size_t WS_WIN = 40 * MiB;
constexpr size_t WS_WOUT = WS_WIN + 96 * MiB;
constexpr size_t WS_WUP = WS_WOUT + 32 * MiB;
constexpr size_t WS_WDN = WS_WUP + 172 * MiB;
constexpr size_t WS_WL2 = WS_WDN + 86 * MiB;
constexpr size_t WS_X1 = WS_WL2 + 6 * MiB;
constexpr size_t WS_H = WS_X1 + 192 * MiB;
constexpr size_t WS_BIG = WS_H + 96 * MiB;
constexpr size_t WS_U = WS_BIG;
constexpr size_t WS_G = WS_BIG + 516 * MiB;
constexpr size_t WS_RKVG = WS_BIG;
constexpr size_t WS_QKV = WS_BIG + 144 * MiB;
constexpr size_t WS_LH = WS_BIG + 204 * MiB;
constexpr size_t WS_HYT = WS_BIG + 216 * MiB;
constexpr size_t WS_LW = WS_BIG + 288 * MiB;
constexpr size_t WS_MIX = WS_BIG + 432 * MiB;
constexpr size_t WS_OF = WS_BIG + 528 * MiB;
constexpr size_t WS_OB = WS_BIG + 600 * MiB;
constexpr size_t WS_HYO = WS_BIG + 672 * MiB;
constexpr size_t WS_BS = WS_BIG + 696 * MiB;
constexpr size_t WS_INV = WS_BIG + 700 * MiB;
constexpr size_t WS_HALO = WS_BIG + 774 * MiB;
constexpr size_t WS_END = WS_HALO + 18 * MiB;
static_assert(WS_END <= 1536 * MiB, "workspace");

constexpr int CW_BAR = 4096;
constexpr int CW_Q = 16384;

constexpr int LDS_BYTES = 147456;
constexpr int LDS_MISC = 147456 - 256;

__device__ __forceinline__ unsigned f2bf(float f) { unsigned u = __float_as_uint(f); return (u + 0x7fffu + ((u >> 16) & 1u)) >> 16; }
__device__ __forceinline__ float bf2f(unsigned b) { return __uint_as_float(b << 16); }
__device__ __forceinline__ unsigned pk2(float lo, float hi) { hwbf16x2 b = __builtin_convertvector((f32x2){lo, hi}, hwbf16x2); return __builtin_bit_cast(unsigned, b); }
__device__ __forceinline__ float bflo(unsigned w) { return __uint_as_float(w << 16); }
__device__ __forceinline__ float bfhi(unsigned w) { return __uint_as_float(w & 0xffff0000u); }
__device__ __forceinline__ float sigmoidf_(float x) { return 1.0f / (1.0f + __expf(-x)); }
__device__ __forceinline__ float siluf_(float x) { return x / (1.0f + __expf(-x)); }
#define VM_WAIT() asm volatile("s_waitcnt vmcnt(0)" ::: "memory")

namespace pg8 {
#define PG8_LAS __attribute__((address_space(3)))
typedef unsigned short bf16_t;
typedef short bf16x8 __attribute__((ext_vector_type(8)));
typedef float f32x4 __attribute__((ext_vector_type(4)));
typedef unsigned u32x4 __attribute__((ext_vector_type(4)));
constexpr int BM = 256, BK = 64, HALF = 128, HTB = HALF * BK * 2  , STAGE_BYTES = 8 * HTB, NXCD = 8, WGM = 8;

__host__ __device__ __forceinline__ int lds_byte(int r, int c) { const int st = (r >> 4) * 2 + (c >> 5), rr = r & 15, cc = c & 31, ob = rr * 64 + cc * 2; return st * 1024 + (ob ^ (((ob >> 9) & 1) << 5)); }
__host__ __device__ __forceinline__ void stage_rc(int b, int& R, int& C) { const int st = b / 1024, sb = b % 1024, swz = sb ^ (((sb >> 9) & 1) << 5); R = (st >> 1) * 16 + swz / 64; C = (st & 1) * 32 + (swz % 64) / 2; }
__host__ __device__ __forceinline__ int perm32(int rho) { const int n = rho >> 4, i = rho & 15; return 8 * (i >> 2) + 4 * n + (i & 3); }

struct Unit { int pm, pn; };
struct Gemm { const bf16_t* A; const bf16_t* Bt; int M, N, K; };

struct StaticOrder {
    int nM, nN, nwg, G, c;
    __host__ __device__ void init(int M, int N, int G_, int c_) { nM = M / BM; nN = N / BM; nwg = nM * nN; G = G_; c = c_; }
    __host__ __device__ bool next(int i, Unit& u) const {
        const long L = (long)i * G + c; if (L >= nwg) return false;
        int wgid = (int)L; { const int q = nwg / NXCD, r = nwg % NXCD, xcd = wgid % NXCD, off = wgid / NXCD; wgid = (xcd < r ? xcd * (q + 1) : r * (q + 1) + (xcd - r) * q) + off; }
        const int nig = WGM * nN, gid = wgid / nig, fm = gid * WGM, gsz = (nM - fm) < WGM ? (nM - fm) : WGM;
        u.pm = fm + ((wgid % nig) % gsz); u.pn = (wgid % nig) / gsz; return true;
    }
    __device__ __forceinline__ void a_ready(const Unit&) const {}
    __device__ __forceinline__ void done(const Unit&) const {}
};

__device__ __forceinline__ unsigned cvt_pk_bf16(float lo, float hi) { unsigned r; asm volatile("v_cvt_pk_bf16_f32 %0, %1, %2" : "=v"(r) : "v"(lo), "v"(hi)); return r; }

struct EpiPlain {
    static constexpr bool PERM = true, AFTER_DRAIN = false;
    bf16_t* O; int ldc;
    __device__ __forceinline__ void operator()(const f32x4 (&acc)[2][2][4][2], const Unit& u, int wr, int wc, int fr, int fq) const {
        const int row0 = u.pm * BM + wr * 64 + fr, col0 = u.pn * BM + wc * 32 + 8 * fq;
#pragma unroll
        for (int ai = 0; ai < 2; ++ai)
#pragma unroll
            for (int m = 0; m < 4; ++m) { bf16_t* rowp = O + (size_t)(row0 + ai * HALF + m * 16) * ldc + col0;
#pragma unroll
                for (int bj = 0; bj < 2; ++bj) { const f32x4 v0 = acc[ai][bj][m][0], v1 = acc[ai][bj][m][1];
                    u32x4 w; w.x = cvt_pk_bf16(v0[0], v0[1]); w.y = cvt_pk_bf16(v0[2], v0[3]); w.z = cvt_pk_bf16(v1[0], v1[1]); w.w = cvt_pk_bf16(v1[2], v1[3]);
                    *(u32x4*)(rowp + bj * HALF) = w; } }
    }
};

struct Epi1 {
    static constexpr bool PERM = true, AFTER_DRAIN = false;
    bf16_t* rkvg; bf16_t* qkv; bf16_t* lh; bf16_t* hyt; float* ck; float* cv; int layer; int Mrows;
    __device__ __forceinline__ void operator()(const f32x4 (&acc)[2][2][4][2], const Unit& u, int wr, int wc, int fr, int fq) const {
        const int row0 = u.pm * BM + wr * 64 + fr, cw = wc * 32 + 8 * fq, pn = u.pn;
        if (pn >= 12 && pn < 18) {
            const int c0 = (pn - 12) * BM + cw;
#pragma unroll
            for (int ai = 0; ai < 2; ++ai)
#pragma unroll
                for (int m = 0; m < 4; ++m) { const int row = row0 + ai * HALF + m * 16;
#pragma unroll
                    for (int bj = 0; bj < 2; ++bj)
#pragma unroll
                        for (int n = 0; n < 2; ++n)
#pragma unroll
                            for (int e = 0; e < 4; ++e) {
                                const unsigned w = cvt_pk_bf16(acc[ai][bj][m][n][e], 0.f);
                                hyt[(size_t)(c0 + bj * HALF + 4 * n + e) * Mrows + row] = (bf16_t)w; } }
            return;
        }
        bf16_t* base; int ldc; int coff; bool th = false; float* fdst = nullptr;
        if (pn < 12) { base = rkvg; ldc = 3072; coff = pn * BM; }
        else if (pn < 21) { base = qkv; ldc = 1280; coff = (pn - 18) * BM; }
        else if (pn == 21) { base = qkv; ldc = 1280; coff = 768; fdst = ck; }
        else if (pn == 22) { base = qkv; ldc = 1280; coff = 1024; fdst = cv; }
        else { base = lh; ldc = 256; coff = 0; th = true; }
        if (u.pm >= 32) fdst = nullptr;
#pragma unroll
        for (int ai = 0; ai < 2; ++ai)
#pragma unroll
            for (int m = 0; m < 4; ++m) { const int row = row0 + ai * HALF + m * 16; bf16_t* rowp = base + (size_t)row * ldc + coff + cw;
#pragma unroll
                for (int bj = 0; bj < 2; ++bj) { f32x4 v0 = acc[ai][bj][m][0], v1 = acc[ai][bj][m][1];
                    if (th && bj == 0) {
#pragma unroll
                        for (int e = 0; e < 4; ++e) { v0[e] = tanhf(v0[e]); v1[e] = tanhf(v1[e]); } }
                    u32x4 w; w.x = cvt_pk_bf16(v0[0], v0[1]); w.y = cvt_pk_bf16(v0[2], v0[3]); w.z = cvt_pk_bf16(v1[0], v1[1]); w.w = cvt_pk_bf16(v1[2], v1[3]);
                    *(u32x4*)(rowp + bj * HALF) = w;
                    if (fdst) { float* fp = fdst + ((size_t)(u.pm * 4 + layer) * 256 + (row & 255)) * 256 + cw + bj * HALF; *(f32x4*)fp = v0; *(f32x4*)(fp + 4) = v1; } } }
    }
};


struct EpiGate {
    static constexpr bool PERM = true, AFTER_DRAIN = false;
    bf16_t* G; const float* cw; float* halo; PG8_LAS unsigned char* edge;
    template <int CTRL> static __device__ __forceinline__ float dpp(float x) { return __int_as_float(__builtin_amdgcn_update_dpp(0, __float_as_int(x), CTRL, 0xf, 0xf, false)); }
    __device__ __forceinline__ void operator()(const f32x4 (&acc)[2][2][4][2], const Unit& u, int wr, int wc, int fr, int fq) const {
        const int cw0 = wc * 32 + 8 * fq, j0 = u.pn * 128 + cw0;
        PG8_LAS float* E = (PG8_LAS float*)edge;
#pragma unroll
        for (int ai = 0; ai < 2; ++ai) { const int g4 = 2 * ai + wr;
            if (fr == 0) {
#pragma unroll
                for (int bj = 0; bj < 2; ++bj)
#pragma unroll
                    for (int n = 0; n < 2; ++n) *(PG8_LAS f32x4*)(E + (g4 * 2 + 0) * 256 + bj * HALF + cw0 + 4 * n) = acc[ai][bj][0][n]; }
            if (fr == 15) {
#pragma unroll
                for (int bj = 0; bj < 2; ++bj)
#pragma unroll
                    for (int n = 0; n < 2; ++n) *(PG8_LAS f32x4*)(E + (g4 * 2 + 1) * 256 + bj * HALF + cw0 + 4 * n) = acc[ai][bj][3][n]; }
        }
        if (wr == 0 && fr < 2) { float* hp = halo + ((size_t)u.pm * 4 + fr) * 11008 + j0;
#pragma unroll
            for (int n = 0; n < 2; ++n) { *(f32x4*)(hp + 4 * n) = acc[0][0][0][n]; *(f32x4*)(hp + 5504 + 4 * n) = acc[0][1][0][n]; } }
        if (wr == 1 && fr >= 14) { float* hp = halo + ((size_t)u.pm * 4 + 2 + (fr - 14)) * 11008 + j0;
#pragma unroll
            for (int n = 0; n < 2; ++n) { *(f32x4*)(hp + 4 * n) = acc[1][0][3][n]; *(f32x4*)(hp + 5504 + 4 * n) = acc[1][1][3][n]; } }
        asm volatile("s_waitcnt lgkmcnt(0)" ::: "memory"); __builtin_amdgcn_s_barrier(); asm volatile("" ::: "memory");
        const int row0 = u.pm * BM + wr * 64 + fr;
#pragma unroll
        for (int ai = 0; ai < 2; ++ai) { const int g4 = 2 * ai + wr;
#pragma unroll
            for (int n = 0; n < 2; ++n) {
                f32x4 ca[4];
                { f32x4 w[3];
#pragma unroll
                  for (int tp = 0; tp < 3; ++tp) w[tp] = *(const f32x4*)(cw + tp * 11008 + j0 + 4 * n);
                  f32x4 pe = (f32x4){0.f, 0.f, 0.f, 0.f}, ne = pe;
                  if (g4 > 0) pe = *(const PG8_LAS f32x4*)(E + ((g4 - 1) * 2 + 1) * 256 + cw0 + 4 * n);
                  if (g4 < 3) ne = *(const PG8_LAS f32x4*)(E + ((g4 + 1) * 2 + 0) * 256 + cw0 + 4 * n);
#pragma unroll
                  for (int m = 0; m < 4; ++m) { const f32x4 v = acc[ai][0][m][n], vp = (m > 0) ? acc[ai][0][m - 1][n] : pe, vn = (m < 3) ? acc[ai][0][m + 1][n] : ne;
#pragma unroll
                      for (int e = 0; e < 4; ++e) { const float prev = dpp<0x121>((fr == 15) ? vp[e] : v[e]), next = dpp<0x12F>((fr == 0) ? vn[e] : v[e]); ca[m][e] = w[0][e] * prev + w[1][e] * v[e] + w[2][e] * next; } } }
                { f32x4 w[3];
#pragma unroll
                  for (int tp = 0; tp < 3; ++tp) w[tp] = *(const f32x4*)(cw + tp * 11008 + 5504 + j0 + 4 * n);
                  f32x4 pe = (f32x4){0.f, 0.f, 0.f, 0.f}, ne = pe;
                  if (g4 > 0) pe = *(const PG8_LAS f32x4*)(E + ((g4 - 1) * 2 + 1) * 256 + HALF + cw0 + 4 * n);
                  if (g4 < 3) ne = *(const PG8_LAS f32x4*)(E + ((g4 + 1) * 2 + 0) * 256 + HALF + cw0 + 4 * n);
#pragma unroll
                  for (int m = 0; m < 4; ++m) { const f32x4 v = acc[ai][1][m][n], vp = (m > 0) ? acc[ai][1][m - 1][n] : pe, vn = (m < 3) ? acc[ai][1][m + 1][n] : ne; float o[4];
#pragma unroll
                      for (int e = 0; e < 4; ++e) { const float prev = dpp<0x121>((fr == 15) ? vp[e] : v[e]), next = dpp<0x12F>((fr == 0) ? vn[e] : v[e]); const float cb = w[0][e] * prev + w[1][e] * v[e] + w[2][e] * next;
                          const float a = ca[m][e]; o[e] = a * __builtin_amdgcn_rcpf(1.0f + __expf(-a)) * cb; }
                      u32x2 wv; wv.x = cvt_pk_bf16(o[0], o[1]); wv.y = cvt_pk_bf16(o[2], o[3]);
                      *(u32x2*)(G + (size_t)(row0 + ai * HALF + m * 16) * 5504 + j0 + 4 * n) = wv; } }
            }
        }
    }
};

struct EpiRes {
    static constexpr bool PERM = false, AFTER_DRAIN = false;
    const float* xa; const float* xb; int nrows_a; const float* gate;   int gstride; float* dst; int ldc; float alpha;
    __device__ __forceinline__ void operator()(const f32x4 (&acc)[2][2][4][2], const Unit& u, int wr, int wc, int fr, int fq) const {
        const int row0 = u.pm * BM + wr * 64 + fr, col0 = u.pn * BM + wc * 32 + 4 * fq;
        const int bi = (u.pm < 32) ? 8 : ((u.pm - 32) >> 3);
        const float* gp = gate + (size_t)bi * gstride + col0;
        f32x4 gv[2][2];
#pragma unroll
        for (int bj = 0; bj < 2; ++bj)
#pragma unroll
            for (int n = 0; n < 2; ++n) gv[bj][n] = *(const f32x4*)(gp + bj * HALF + n * 16);
#pragma unroll
        for (int ai = 0; ai < 2; ++ai)
#pragma unroll
            for (int m = 0; m < 4; ++m) { const int row = row0 + ai * HALF + m * 16;
                const float* xp = (row < nrows_a ? xa + (size_t)row * ldc : xb + (size_t)(row - nrows_a) * ldc) + col0; float* dp = dst + (size_t)row * ldc + col0;
#pragma unroll
                for (int bj = 0; bj < 2; ++bj)
#pragma unroll
                    for (int n = 0; n < 2; ++n) { const f32x4 xv = *(const f32x4*)(xp + bj * HALF + n * 16);
                        *(f32x4*)(dp + bj * HALF + n * 16) = xv * alpha + gv[bj][n] * acc[ai][bj][m][n]; } }
    }
};

template <class Epi, class Sched, bool ALIGN_EPI = false, bool SP2 = false>
__device__ __forceinline__ void gemm_phase(PG8_LAS unsigned char* lds, const Gemm g, const Sched& S, const Epi& E) {
    int tid = threadIdx.x; asm volatile("" : "+v"(tid)); const int wid = __builtin_amdgcn_readfirstlane(tid >> 6), lane = tid & 63, wr = wid >> 2, wc = wid & 3, fr = lane & 15, fq = lane >> 4;
    const int K = g.K, nt = K / BK;
    unsigned voffA[2], voffB[2];
#pragma unroll
    for (int i = 0; i < 2; ++i) { int R, C; stage_rc(tid * 16 + i * 8192, R, C); const int Rb = Epi::PERM ? ((R & ~31) + perm32(R & 31)) : R;
        voffA[i] = (unsigned)(R * K + C) * 2u; voffB[i] = (unsigned)(Rb * K + C) * 2u; }
    const size_t kstep = (size_t)(BK * 2);
    const size_t hstep = (size_t)HALF * K * 2;
    const size_t tstep = 2 * hstep;
    const unsigned ldsw = (unsigned)wid * 1024u;
    const int aoff = lds_byte(wr * 64 + fr, fq * 8), boff = lds_byte(wc * 32 + fr, fq * 8);
#define PG8_SA(b, h) (((b) * 2 + (h)) * HTB)
#define PG8_SB(b, h) ((4 + (b) * 2 + (h)) * HTB)
#define PG8_STAGE(bufoff, gbase, voff) do { _Pragma("unroll") for (int _i = 0; _i < 2; ++_i) \
        __builtin_amdgcn_global_load_lds((const unsigned*)((const char*)(gbase) + (voff)[_i]), (PG8_LAS unsigned*)(lds + (bufoff) + ldsw + _i * 8192), 16, 0, 0); } while (0)
#define PG8_LDA(dst, b, h) do { _Pragma("unroll") for (int m = 0; m < 4; ++m) _Pragma("unroll") for (int k = 0; k < 2; ++k) dst[m][k] = *(const PG8_LAS bf16x8*)(lds + PG8_SA(b, h) + aoff + m * 2048 + k * 1024); } while (0)
#define PG8_LDB(dst, b, h) do { _Pragma("unroll") for (int n = 0; n < 2; ++n) _Pragma("unroll") for (int k = 0; k < 2; ++k) dst[n][k] = *(const PG8_LAS bf16x8*)(lds + PG8_SB(b, h) + boff + n * 2048 + k * 1024); } while (0)
#define PG8_MMA(ai, bj, At, Bt) do { __builtin_amdgcn_s_setprio(1); _Pragma("unroll") for (int m = 0; m < 4; ++m) _Pragma("unroll") for (int n = 0; n < 2; ++n) _Pragma("unroll") for (int k = 0; k < 2; ++k) \
        acc[ai][bj][m][n] = __builtin_amdgcn_mfma_f32_16x16x32_bf16(Bt[n][k], At[m][k], acc[ai][bj][m][n], 0, 0, 0); __builtin_amdgcn_s_setprio(0); } while (0)
#define PG8_WAIT_V(n) asm volatile("s_waitcnt vmcnt(" #n ")" ::: "memory")
#define PG8_WAIT_L(n) asm volatile("s_waitcnt lgkmcnt(" #n ")" ::: "memory")
#define PG8_BAR __builtin_amdgcn_s_barrier()
#define PG8_SCHED __builtin_amdgcn_sched_barrier(0)
    Unit cur, nxt; int ui = 0;
    if (!S.next(0, cur)) return;
    f32x4 acc[2][2][4][2];
#pragma unroll
    for (int a = 0; a < 2; ++a)
#pragma unroll
        for (int b = 0; b < 2; ++b)
#pragma unroll
            for (int m = 0; m < 4; ++m)
#pragma unroll
                for (int n = 0; n < 2; ++n) acc[a][b][m][n] = (f32x4){0.f, 0.f, 0.f, 0.f};
    bf16x8 At[4][2], B0[2][2], B1[2][2];
    const char* cA = (const char*)g.A + (size_t)cur.pm * tstep; const char* cB = (const char*)g.Bt + (size_t)cur.pn * tstep;
    S.a_ready(cur);
    if constexpr (SP2) {
        PG8_STAGE(PG8_SB(0, 0), cB, voffB); PG8_STAGE(PG8_SB(0, 1), cB + hstep, voffB); PG8_STAGE(PG8_SA(0, 0), cA, voffA); PG8_STAGE(PG8_SA(0, 1), cA + hstep, voffA);
        if (wr == 1) PG8_BAR;
        PG8_WAIT_V(2); PG8_BAR;
        PG8_STAGE(PG8_SB(1, 0), cB + kstep, voffB); PG8_STAGE(PG8_SA(1, 0), cA + kstep, voffA); PG8_STAGE(PG8_SB(1, 1), cB + hstep + kstep, voffB);
        PG8_WAIT_V(6); PG8_BAR;
    } else {
        PG8_STAGE(PG8_SB(0, 0), cB, voffB); PG8_STAGE(PG8_SA(0, 0), cA, voffA); PG8_STAGE(PG8_SB(0, 1), cB + hstep, voffB); PG8_STAGE(PG8_SA(0, 1), cA + hstep, voffA);
        if (wr == 1) PG8_BAR;
        PG8_WAIT_V(4); PG8_BAR;
        PG8_STAGE(PG8_SB(1, 0), cB + kstep, voffB); PG8_STAGE(PG8_SA(1, 0), cA + kstep, voffA); PG8_STAGE(PG8_SB(1, 1), cB + hstep + kstep, voffB);
        PG8_WAIT_V(6); PG8_BAR;
    }
    for (;;) {
        const bool has_next = S.next(ui + 1, nxt);
        const char* nA = has_next ? (const char*)g.A + (size_t)nxt.pm * tstep : cA; const char* nB = has_next ? (const char*)g.Bt + (size_t)nxt.pn * tstep : cB;
        for (int t = 0; t < nt; t += 2) {
            const bool last = (t == nt - 2);
            const char* a1 = cA + (size_t)(t + 1) * kstep;
            const char* a2 = last ? nA : cA + (size_t)(t + 2) * kstep; const char* b2 = last ? nB : cB + (size_t)(t + 2) * kstep;
            const char* a3 = a2 + kstep; const char* b3 = b2 + kstep;
            if (last && has_next) S.a_ready(nxt);
            if constexpr (SP2) {
            PG8_LDB(B0, 0, 0); PG8_LDB(B1, 0, 1); PG8_SCHED; PG8_LDA(At, 0, 0); PG8_STAGE(PG8_SA(1, 1), a1 + hstep, voffA);
            PG8_WAIT_V(8); PG8_WAIT_L(0); PG8_BAR; PG8_MMA(0, 0, At, B0); PG8_MMA(0, 1, At, B1); PG8_BAR; PG8_SCHED;
            PG8_LDA(At, 0, 1); PG8_STAGE(PG8_SB(0, 0), b2, voffB); PG8_STAGE(PG8_SB(0, 1), b2 + hstep, voffB); PG8_STAGE(PG8_SA(0, 0), a2, voffA);
            PG8_WAIT_V(8); PG8_WAIT_L(0); PG8_BAR; PG8_MMA(1, 0, At, B0); PG8_MMA(1, 1, At, B1); PG8_BAR; PG8_SCHED;
            PG8_LDB(B0, 1, 0); PG8_LDB(B1, 1, 1); PG8_SCHED; PG8_LDA(At, 1, 0); PG8_STAGE(PG8_SA(0, 1), a2 + hstep, voffA);
            PG8_WAIT_V(8); PG8_WAIT_L(0); PG8_BAR; PG8_MMA(0, 0, At, B0); PG8_MMA(0, 1, At, B1); PG8_BAR; PG8_SCHED;
            PG8_LDA(At, 1, 1); PG8_STAGE(PG8_SB(1, 0), b3, voffB); PG8_STAGE(PG8_SB(1, 1), b3 + hstep, voffB); PG8_STAGE(PG8_SA(1, 0), a3, voffA);
            PG8_WAIT_V(8); PG8_WAIT_L(0); PG8_BAR; PG8_MMA(1, 0, At, B0); PG8_MMA(1, 1, At, B1); PG8_BAR; PG8_SCHED;
            } else {
            PG8_LDB(B0, 0, 0); PG8_SCHED; PG8_LDA(At, 0, 0); PG8_STAGE(PG8_SA(1, 1), a1 + hstep, voffA);
            PG8_WAIT_L(8); PG8_BAR; PG8_WAIT_L(0); PG8_MMA(0, 0, At, B0); PG8_BAR; PG8_SCHED;
            PG8_LDB(B1, 0, 1); PG8_STAGE(PG8_SB(0, 0), b2, voffB);
            PG8_BAR; PG8_WAIT_L(0); PG8_MMA(0, 1, At, B1); PG8_BAR;
            PG8_LDA(At, 0, 1); PG8_STAGE(PG8_SA(0, 0), a2, voffA);
            PG8_BAR; PG8_WAIT_L(0); PG8_MMA(1, 0, At, B0); PG8_BAR; PG8_SCHED;
            PG8_STAGE(PG8_SB(0, 1), b2 + hstep, voffB);
            PG8_WAIT_V(6); PG8_BAR; PG8_MMA(1, 1, At, B1); PG8_BAR;
            PG8_LDB(B0, 1, 0); PG8_SCHED; PG8_LDA(At, 1, 0); PG8_STAGE(PG8_SA(0, 1), a2 + hstep, voffA);
            PG8_WAIT_L(8); PG8_BAR; PG8_WAIT_L(0); PG8_MMA(0, 0, At, B0); PG8_BAR; PG8_SCHED;
            PG8_LDB(B1, 1, 1); PG8_STAGE(PG8_SB(1, 0), b3, voffB);
            PG8_BAR; PG8_WAIT_L(0); PG8_MMA(0, 1, At, B1); PG8_BAR;
            PG8_LDA(At, 1, 1); PG8_STAGE(PG8_SA(1, 0), a3, voffA);
            PG8_BAR; PG8_WAIT_L(0); PG8_MMA(1, 0, At, B0); PG8_BAR; PG8_SCHED;
            PG8_STAGE(PG8_SB(1, 1), b3 + hstep, voffB);
            PG8_WAIT_V(6); PG8_BAR; PG8_MMA(1, 1, At, B1); PG8_BAR;
            }
        }
        if constexpr (ALIGN_EPI) { if (wr == 0) PG8_BAR; }
        if constexpr (!Epi::AFTER_DRAIN) { E(acc, cur, wr, wc, fr, fq); S.done(cur); }
        if (!has_next) break;
#pragma unroll
        for (int a = 0; a < 2; ++a)
#pragma unroll
            for (int b = 0; b < 2; ++b)
#pragma unroll
                for (int m = 0; m < 4; ++m)
#pragma unroll
                    for (int n = 0; n < 2; ++n) acc[a][b][m][n] = (f32x4){0.f, 0.f, 0.f, 0.f};
        cur = nxt; cA = nA; cB = nB; ++ui;
        if constexpr (ALIGN_EPI) { if (wr == 1) PG8_BAR; }
    }
    PG8_WAIT_V(0);
    if constexpr (!ALIGN_EPI) { if (wr == 0) PG8_BAR; }
    PG8_BAR;
    if constexpr (Epi::AFTER_DRAIN) { E.fused(acc, cur, wr, wc, fr, fq, lds, wid, lane); S.done(cur); }
#undef PG8_SA
#undef PG8_SB
#undef PG8_STAGE
#undef PG8_LDA
#undef PG8_LDB
#undef PG8_MMA
#undef PG8_WAIT_V
#undef PG8_WAIT_L
#undef PG8_BAR
#undef PG8_SCHED
}
}

#define XB_TMO      128
#define XB_XCNT(j)  (256  + 64 * (j))
#define XB_XSUB(j)  (1280 + 64 * (j))
#define XB_XGEN(j)  (2304 + 64 * (j))
#define XB_TOP      3328
#define XB_TOPGEN   3392
#define XCD_BAR_WORDS 3456
#define XB_SPIN_CAP (1u << 18)

__device__ __forceinline__ unsigned xb_ld(unsigned* p)              { return __hip_atomic_load(p, __ATOMIC_RELAXED, __HIP_MEMORY_SCOPE_AGENT); }
__device__ __forceinline__ unsigned xb_add(unsigned* p, unsigned v) { return __hip_atomic_fetch_add(p, v, __ATOMIC_RELAXED, __HIP_MEMORY_SCOPE_AGENT); }
__device__ __forceinline__ unsigned xb_xcc_id() { return (unsigned)__builtin_amdgcn_s_getreg((3 << 11) | 20) & 0xFu; }
#define XB_SPIN(cond, bar) do { unsigned _sp = 0; while (cond) { __builtin_amdgcn_s_sleep(1); \
    if ((++_sp & 255u) == 0u) { if (xb_ld(&(bar)[XB_TMO])) break; if (_sp > XB_SPIN_CAP) { atomicAdd(&(bar)[XB_TMO], 1u); break; } } } } while (0)

struct XcdBarrier {
    unsigned* bar; unsigned x;
    volatile LAS unsigned* st;
};

__device__ __forceinline__ XcdBarrier xcd_barrier_post(unsigned* bar, volatile LAS unsigned* st) {
    XcdBarrier b; b.bar = bar; b.x = xb_xcc_id(); b.st = st;
    if (threadIdx.x == 0) (void)xb_add(&bar[XB_XCNT(b.x)], 1u);
    return b;
}
__device__ __forceinline__ void xcd_barrier_complete(unsigned* bar, unsigned x, unsigned& nloc, unsigned& nx) {
    const unsigned G = gridDim.x * gridDim.y * gridDim.z;
    unsigned sum, cnt, mine, sp = 0u;
    for (;;) {
        sum = 0u; cnt = 0u; mine = 0u;
#pragma unroll
        for (unsigned j = 0; j < 16; ++j) { const unsigned c = xb_ld(&bar[XB_XCNT(j)]); sum += c; cnt += (c > 0u) ? 1u : 0u; mine = (j == x) ? c : mine; }
        if (sum == G) break;
        __builtin_amdgcn_s_sleep(1);
        if ((++sp & 255u) == 0u) { if (xb_ld(&bar[XB_TMO])) break; if (sp > XB_SPIN_CAP) { atomicAdd(&bar[XB_TMO], 1u); break; } }
    }
    nloc = mine > 0u ? mine : 1u; nx = cnt > 0u ? cnt : 1u;
}

__device__ __forceinline__ void xcd_barrier(const XcdBarrier& b) {
    asm volatile("s_waitcnt vmcnt(0)" ::: "memory");
    __syncthreads();
    if (threadIdx.x == 0) {
        unsigned* bar = b.bar;
        __builtin_amdgcn_s_waitcnt(0);
        unsigned nloc = b.st[0], nx = b.st[1];
        if (nloc == 0u) { xcd_barrier_complete(bar, b.x, nloc, nx); b.st[0] = nloc; b.st[1] = nx; }
        const unsigned old = xb_add(&bar[XB_XSUB(b.x)], 1u);
        const unsigned gen = old / nloc;
        if (old + 1u == (gen + 1u) * nloc) {
            __builtin_amdgcn_fence(__ATOMIC_RELEASE, "agent");
            asm volatile("s_waitcnt vmcnt(0)" ::: "memory");
            const unsigned og = xb_add(&bar[XB_TOP], 1u);
            const unsigned tg = og / nx;
            if (og + 1u == (tg + 1u) * nx) xb_add(&bar[XB_TOPGEN], 1u);
            else XB_SPIN(xb_ld(&bar[XB_TOPGEN]) == tg, bar);
            __builtin_amdgcn_fence(__ATOMIC_ACQUIRE, "agent");
            xb_add(&bar[XB_XGEN(b.x)], 1u);
            asm volatile("s_waitcnt vmcnt(0)" ::: "memory");
        } else {
            XB_SPIN(xb_ld(&bar[XB_XGEN(b.x)]) == gen, bar);
            __builtin_amdgcn_fence(__ATOMIC_ACQUIRE, "agent");
            asm volatile("s_waitcnt vmcnt(0)" ::: "memory");
        }
    }
    __syncthreads();
}


struct Params { const float* in[N_IN]; float* out; unsigned char* ws; };

struct Ctx {
    LAS unsigned char* lds; int tid, lane, wave, G, bid;
    const float* const* in; float* out; unsigned char* ws; unsigned* ctl;
};

__device__ __forceinline__ float wave_sum(float v) {
#pragma unroll
    for (int o = 32; o >= 1; o >>= 1) v += __shfl_xor(v, o);
    return v;
}
template <int CTRL> __device__ __forceinline__ float dpp_f(float x) { return __int_as_float(__builtin_amdgcn_update_dpp(0, __float_as_int(x), CTRL, 0xf, 0xf, false)); }
__device__ __forceinline__ float row16_sum(float x) { x += dpp_f<0x128>(x); x += dpp_f<0x124>(x); x += dpp_f<0x122>(x); x += dpp_f<0x121>(x); return x; }

__device__ __forceinline__ Ctx relaunder(const Ctx& C) { Ctx R = C; int t = C.tid; asm volatile("" : "+v"(t)); R.tid = t; R.lane = t & 63; R.wave = __builtin_amdgcn_readfirstlane(t >> 6); return R; }

__device__ __forceinline__ int queue_pop(const Ctx& C, int qid) {
    volatile LAS int* slot = (volatile LAS int*)(C.lds + LDS_MISC + 16);
    __syncthreads();
    if (C.tid == 0) *slot = (int)__hip_atomic_fetch_add(C.ctl + CW_Q + 64 * qid, 1u, __ATOMIC_RELAXED, __HIP_MEMORY_SCOPE_AGENT);
    __syncthreads();
    return *slot;
}

__device__ __forceinline__ void tr_decode(const Ctx& C, int job, const float*& src, int& ldsrc, bf16*& dst, int& lddst) {
    constexpr int TPL = 12352;
    const int l = job / TPL, ti = job % TPL;
    if (ti < 2944) { const int kt = ti / 92, nt = ti % 92; src = C.in[I_WIN] + (size_t)l * D * INW + (size_t)kt * 64 * INW + nt * 64; ldsrc = INW;
        dst = (bf16*)(C.ws + WS_WIN) + (size_t)l * N1 * D + (size_t)nt * 64 * D + kt * 64; lddst = D; }
    else if (ti < 3072) { const int t = ti - 2944, i = t >> 5, kt = t & 31; src = C.in[(i < 2) ? I_W1 : I_A1] + ((size_t)(l * 2 + (i & 1)) * D + kt * 64) * 64; ldsrc = 64;
        dst = (bf16*)(C.ws + WS_WIN) + (size_t)l * N1 * D + (size_t)(INW + 64 * i) * D + kt * 64; lddst = D; }
    else if (ti < 4096) { const int t = ti - 3072, kt = t >> 5, nt = t & 31; src = C.in[I_WOUT] + (size_t)l * D * D + (size_t)kt * 64 * D + nt * 64; ldsrc = D;
        dst = (bf16*)(C.ws + WS_WOUT) + (size_t)l * D * D + (size_t)nt * 64 * D + kt * 64; lddst = D; }
    else if (ti < 9600) { const int t = ti - 4096, kt = t / 172, nt = t % 172; src = C.in[I_WUP] + (size_t)l * D * NUP + (size_t)kt * 64 * NUP + nt * 64; ldsrc = NUP;
        const int c0 = nt * 64, cb = (c0 < DFF) ? c0 : c0 - DFF, r0 = (cb >> 7) * 256 + ((c0 < DFF) ? 0 : 128) + (cb & 127);
        dst = (bf16*)(C.ws + WS_WUP) + (size_t)l * NUP * D + (size_t)r0 * D + kt * 64; lddst = D; }
    else { const int t = ti - 9600, kt = t >> 5, nt = t & 31; src = C.in[I_WDN] + (size_t)l * DFF * D + (size_t)kt * 64 * D + nt * 64; ldsrc = D;
        dst = (bf16*)(C.ws + WS_WDN) + (size_t)l * D * DFF + (size_t)nt * 64 * DFF + kt * 64; lddst = DFF; }
}
__device__ __forceinline__ void p0_transposes(const Ctx& C) {
    constexpr int TPL = 12352, NT = DEPTH * TPL, TB = 8;
    LAS float* tiles = (LAS float*)C.lds;
    const int tid = C.tid;
    for (int jb = C.bid; jb * TB < NT; jb += C.G) {
        f32x4 v[TB][2];
#pragma unroll
        for (int q = 0; q < TB; ++q) { const int job = jb * TB + q; if (job < NT) { const float* src; int ldsrc; bf16* dst; int lddst; tr_decode(C, job, src, ldsrc, dst, lddst);
#pragma unroll
            for (int p = 0; p < 2; ++p) v[q][p] = *(const f32x4*)(src + (size_t)(p * 32 + (tid >> 4)) * ldsrc + (tid & 15) * 4); } }
        __syncthreads();
#pragma unroll
        for (int q = 0; q < TB; ++q) { LAS float* tile = tiles + q * (64 * 65);
#pragma unroll
            for (int p = 0; p < 2; ++p) { const int k = p * 32 + (tid >> 4), n4 = (tid & 15) * 4; tile[k * 65 + n4 + 0] = v[q][p][0]; tile[k * 65 + n4 + 1] = v[q][p][1]; tile[k * 65 + n4 + 2] = v[q][p][2]; tile[k * 65 + n4 + 3] = v[q][p][3]; } }
        __syncthreads();
#pragma unroll
        for (int q = 0; q < TB; ++q) { const int job = jb * TB + q; if (job < NT) { const float* src; int ldsrc; bf16* dst; int lddst; tr_decode(C, job, src, ldsrc, dst, lddst);
            const LAS float* tile = tiles + q * (64 * 65); const int n = tid >> 3, k8 = (tid & 7) * 8; float f[8];
#pragma unroll
            for (int j = 0; j < 8; ++j) f[j] = tile[(k8 + j) * 65 + n];
            u32x4 w; w.x = pk2(f[0], f[1]); w.y = pk2(f[2], f[3]); w.z = pk2(f[4], f[5]); w.w = pk2(f[6], f[7]);
            *(u32x4*)(dst + (size_t)n * lddst + k8) = w; } }
    }
    __syncthreads();
}

__device__ __forceinline__ void p0_wl2(const Ctx& C) {
    const int total = DEPTH * 3072 * 32;
    for (int idx = C.bid * 512 + C.tid; idx < total; idx += C.G * 512) {
        const int l = idx / (3072 * 32), rem = idx % (3072 * 32), n = rem >> 5, k8 = (rem & 31) * 8;
        const int blk = n / 768, j = n % 768, kb = k8 >> 6, kk0 = k8 & 63;
        u32x4 w = (u32x4){0u, 0u, 0u, 0u};
        if (kb == blk) { const float* s = C.in[(blk < 2) ? I_W2 : I_A2] + ((size_t)(l * 2 + (blk & 1)) * 64 + kk0) * 768 + j; float f[8];
#pragma unroll
            for (int e = 0; e < 8; ++e) f[e] = s[(size_t)e * 768];
            w.x = pk2(f[0], f[1]); w.y = pk2(f[2], f[3]); w.z = pk2(f[4], f[5]); w.w = pk2(f[6], f[7]); }
        *(u32x4*)((bf16*)(C.ws + WS_WL2) + ((size_t)l * 3072 + n) * 256 + k8) = w;
    }
}

__device__ __forceinline__ void p0_mod(const Ctx& C) {
    LAS float* sc = (LAS float*)C.lds;
    LAS float* red = (LAS float*)(C.lds + 9 * 2048 * 4);
    __syncthreads();
    for (int i = C.tid; i < 9 * 2048; i += 512) { const int bi = i >> 11, k = i & 2047; const float x = (bi < 8) ? C.in[I_C][bi * 2048 + k] : C.in[I_CCTX][k]; sc[i] = siluf_(x); }
    __syncthreads();
    const int cg = C.tid & 15, kg = C.tid >> 4;
    for (int unit = C.bid; unit < DEPTH * 192; unit += C.G) {
        const int l = unit / 192, cb = (unit % 192) * 64;
        f32x4 acc[9];
#pragma unroll
        for (int bi = 0; bi < 9; ++bi) acc[bi] = (f32x4){0.f, 0.f, 0.f, 0.f};
        const float* wp = C.in[I_WMOD] + ((size_t)l * D + kg * 64) * NMOD + cb + cg * 4;
#pragma unroll 8
        for (int kk = 0; kk < 64; ++kk) { const f32x4 w = *(const f32x4*)(wp + (size_t)kk * NMOD);
#pragma unroll
            for (int bi = 0; bi < 9; ++bi) acc[bi] += w * sc[bi * 2048 + kg * 64 + kk]; }
#pragma unroll
        for (int bi = 0; bi < 9; ++bi)
#pragma unroll
            for (int e = 0; e < 4; ++e) { float v = acc[bi][e]; v += __shfl_xor(v, 16); v += __shfl_xor(v, 32); if (C.lane < 16) red[(C.wave * 9 + bi) * 64 + cg * 4 + e] = v; }
        __syncthreads();
        for (int idx = C.tid; idx < 9 * 64; idx += 512) { const int bi = idx >> 6, c = idx & 63; float s = C.in[I_BMOD][l * NMOD + cb + c];
#pragma unroll
            for (int w = 0; w < 8; ++w) s += red[(w * 9 + bi) * 64 + c];
            ((float*)(C.ws + WS_MOD))[((size_t)l * 9 + bi) * NMOD + cb + c] = s; }
        __syncthreads();
    }
}

__device__ __forceinline__ void p0_filters(const Ctx& C) {
    LAS float* z = (LAS float*)C.lds;
    LAS float* h1 = z + 16 * 33;
    LAS float* h2 = h1 + 16 * 64;
    const float HY_MIN = -3.0701134573253945f, HY_MAX = -15.350567286626973f;
    for (int unit = C.bid; unit < DEPTH * 144; unit += C.G) {
        const int l = unit / 144, u2 = unit % 144, grp = (u2 < 128) ? 0 : 1, jb = grp ? (u2 - 128) : u2, L = grp ? 256 : 2048, j0 = jb * 16;
        __syncthreads();
        for (int idx = C.tid; idx < 16 * 33; idx += 512) { const int jj = idx / 33, e = idx % 33, j = j0 + jj; float v;
            if (e == 0) v = (float)j / (float)(L - 1);
            else { const int band = (e - 1) & 15; const float f = 1e-4f + (float)band * ((15.0f - 1e-4f) / 15.0f); const float ang = 6.283185307179586f * (float)j * f / (float)L; v = (e <= 16) ? cosf(ang) : sinf(ang); }
            z[idx] = v; }
        __syncthreads();
        for (int idx = C.tid; idx < 1024; idx += 512) { const int jj = idx >> 6, o = idx & 63; float s = C.in[I_FB1][l * 64 + o];
            for (int e = 0; e < 33; ++e) s += z[jj * 33 + e] * C.in[I_FW1][((size_t)l * 33 + e) * 64 + o];
            h1[idx] = sinf(C.in[I_FF1][l * 64 + o] * s); }
        __syncthreads();
        for (int idx = C.tid; idx < 1024; idx += 512) { const int jj = idx >> 6, o = idx & 63; float s = C.in[I_FB2][l * 64 + o];
            for (int e = 0; e < 64; ++e) s += h1[jj * 64 + e] * C.in[I_FW2][((size_t)l * 64 + e) * 64 + o];
            h2[idx] = sinf(C.in[I_FF2][l * 64 + o] * s); }
        __syncthreads();
        const int col = C.tid * 4, o = col >> 10, dir = (col >> 9) & 1, c0 = col & 511;
        f32x4 acc[16];
#pragma unroll
        for (int jj = 0; jj < 16; ++jj) acc[jj] = (f32x4){0.f, 0.f, 0.f, 0.f};
        for (int i = 0; i < 64; ++i) { const f32x4 w = *(const f32x4*)(C.in[I_FW3] + ((size_t)l * 64 + i) * 2048 + col);
#pragma unroll
            for (int jj = 0; jj < 16; ++jj) acc[jj] += w * h2[jj * 64 + i]; }
        bf16* fb = (bf16*)(C.ws + WS_FILT + (size_t)l * FILT_LAYER + (grp ? FILT_CTX_OFF : 0));
#pragma unroll
        for (int jj = 0; jj < 16; ++jj) { const int j = j0 + jj; const float t = (float)j / (float)(L - 1);
#pragma unroll
            for (int e = 0; e < 4; ++e) { const int c = c0 + e; const float delta = fabsf(HY_MIN + (float)c * ((HY_MAX - HY_MIN) / 511.0f));
                float val = acc[jj][e] * expf(-t * delta); int eidx = dir ? (L + j) : (L - j);
                if (dir && j == 0) { eidx = 0; val = 0.f; }
                fb[((size_t)(o * 512 + c)) * (2 * L) + eidx] = (bf16)f2bf(val); } }
    }
}

__device__ __forceinline__ void p0_rope(const Ctx& C) {
    float* rc = (float*)(C.ws + WS_ROPE);
    for (int idx = C.bid * 512 + C.tid; idx < 2048 * 32; idx += C.G * 512) { const int t = idx >> 5, i = idx & 31; const float inv = exp2f(-(float)(i & 15) * (13.287712379549449f / 16.0f));
        const float ang = (float)((i < 16) ? (t >> 6) : (t & 63)) * inv; rc[idx] = cosf(ang); rc[65536 + idx] = sinf(ang); }
}

__device__ __forceinline__ void p0_h0(const Ctx& C) {
    const float* mod = (const float*)(C.ws + WS_MOD);
    bf16* H = (bf16*)(C.ws + WS_H);
    const int total = M * (D / 8);
    for (int task = C.bid * 512 + C.tid; task < total; task += C.G * 512) {
        const int row = task >> 8, c8 = (task & 255) * 8;
        const float* xp = (row < MC) ? C.in[I_XP] + (size_t)row * D + c8 : C.in[I_XS] + (size_t)(row - MC) * D + c8;
        const int bi = (row < MC) ? 8 : ((row - MC) >> 11);
        const float* mp = mod + (size_t)bi * NMOD + c8;
        const f32x4 x0 = *(const f32x4*)xp, x1 = *(const f32x4*)(xp + 4), sh0 = *(const f32x4*)mp, sh1 = *(const f32x4*)(mp + 4), s0 = *(const f32x4*)(mp + D), s1 = *(const f32x4*)(mp + D + 4);
        const f32x4 h0 = x0 * (s0 + 1.0f) + sh0, h1 = x1 * (s1 + 1.0f) + sh1;
        u32x4 w; w.x = pk2(h0[0], h0[1]); w.y = pk2(h0[2], h0[3]); w.z = pk2(h1[0], h1[1]); w.w = pk2(h1[2], h1[3]);
        *(u32x4*)(H + (size_t)row * D + c8) = w;
    }
}

__device__ __forceinline__ void ln_phase(const Ctx& C, float* buf, const float* g, const float* b, const float* modl  , int shift_off, int scale_off, bf16* H) {
    const int lane = C.lane;
    f32x4 gv[8], bv[8];
#pragma unroll
    for (int i = 0; i < 8; ++i) { gv[i] = *(const f32x4*)(g + lane * 4 + 256 * i); bv[i] = *(const f32x4*)(b + lane * 4 + 256 * i); }
    for (int row = C.bid * 8 + C.wave; row < M; row += C.G * 8) {
        float* rp = buf + (size_t)row * D + lane * 4;
        f32x4 v[8]; float s = 0.f;
#pragma unroll
        for (int i = 0; i < 8; ++i) { v[i] = *(const f32x4*)(rp + 256 * i); s += (v[i][0] + v[i][1]) + (v[i][2] + v[i][3]); }
        const float mu = wave_sum(s) * (1.0f / 2048.0f);
        float q = 0.f;
#pragma unroll
        for (int i = 0; i < 8; ++i) { v[i] = v[i] - mu; q += (v[i][0] * v[i][0] + v[i][1] * v[i][1]) + (v[i][2] * v[i][2] + v[i][3] * v[i][3]); }
        const float rstd = rsqrtf(wave_sum(q) * (1.0f / 2048.0f) + LN_EPS);
        const int bi = (row < MC) ? 8 : ((row - MC) >> 11);
#pragma unroll
        for (int i = 0; i < 8; ++i) { const f32x4 y = v[i] * rstd * gv[i] + bv[i]; *(f32x4*)(rp + 256 * i) = y;
            if (modl) { const float* mp = modl + (size_t)bi * NMOD + lane * 4 + 256 * i; const f32x4 sh = *(const f32x4*)(mp + shift_off), sc = *(const f32x4*)(mp + scale_off);
                const f32x4 h = y * (sc + 1.0f) + sh; u32x2 w; w.x = pk2(h[0], h[1]); w.y = pk2(h[2], h[3]); *(u32x2*)(H + (size_t)row * D + lane * 4 + 256 * i) = w; } }
    }
}

__device__ __forceinline__ void gate_fixup_phase(const Ctx& C, const float* halo, const float* cw, bf16* Gb) {
    for (int idx = C.bid * 512 + C.tid; idx < 56 * DFF; idx += C.G * 512) {
        const int seam = idx / DFF, j = idx % DFF, p = 32 + (seam / 7) * 8 + (seam % 7);
        const float* h0 = halo + (size_t)p * 4 * 11008; const float* h1 = halo + (size_t)(p + 1) * 4 * 11008;
        const float a254 = h0[2 * 11008 + j], a255 = h0[3 * 11008 + j], a0 = h1[j], a1 = h1[11008 + j];
        const float b254 = h0[2 * 11008 + 5504 + j], b255 = h0[3 * 11008 + 5504 + j], b0 = h1[5504 + j], b1 = h1[11008 + 5504 + j];
        const float wa0 = cw[j], wa1 = cw[11008 + j], wa2 = cw[2 * 11008 + j], wb0 = cw[5504 + j], wb1 = cw[11008 + 5504 + j], wb2 = cw[2 * 11008 + 5504 + j];
        const float ca = wa0 * a254 + wa1 * a255 + wa2 * a0, cb = wb0 * b254 + wb1 * b255 + wb2 * b0;
        const float da = wa0 * a255 + wa1 * a0 + wa2 * a1, db = wb0 * b255 + wb1 * b0 + wb2 * b1;
        Gb[(size_t)(p * 256 + 255) * DFF + j] = (bf16)f2bf(ca * __builtin_amdgcn_rcpf(1.0f + __expf(-ca)) * cb);
        Gb[(size_t)((p + 1) * 256) * DFF + j] = (bf16)f2bf(da * __builtin_amdgcn_rcpf(1.0f + __expf(-da)) * db);
    }
}

constexpr int AT_KS = 72;
constexpr int AT_VS = 72;
constexpr int AT_KOFF = 0, AT_VOFF = 64 * AT_KS * 2;

constexpr int AT_BUF = 2 * 64 * AT_KS * 2;
struct AttnRegs { u32x4 a, b, c, d; };
__device__ __forceinline__ void attn_load(const Ctx& C, AttnRegs& R, bool f32src, const void* kptr, const void* vptr, int ld, bool rope, int tpos0, const float* ropec) {
    const int key = C.tid & 63, part = C.tid >> 6;
    if (f32src) {
        const float* kp = (const float*)kptr + (size_t)key * ld + part * 8; const float* vp = (const float*)vptr + (size_t)key * ld + part * 8;
        R.a = *(const u32x4*)kp; R.b = *(const u32x4*)(kp + 4); R.c = *(const u32x4*)vp; R.d = *(const u32x4*)(vp + 4);
    } else {
        const bf16* kp = (const bf16*)kptr + (size_t)key * ld + part * 8; const bf16* vp = (const bf16*)vptr + (size_t)key * ld + part * 8;
        R.a = *(const u32x4*)kp; R.b = *(const u32x4*)vp;
        if (rope) R.c = *(const u32x4*)((const bf16*)kptr + (size_t)key * ld + (part ^ 4) * 8);
    }
}
__device__ __forceinline__ void attn_write(const Ctx& C, const AttnRegs& R, bool f32src, bool rope, LAS unsigned char* buf, int tpos0, const float* ropec) {
    LAS bf16* Kc = (LAS bf16*)(buf + AT_KOFF); LAS bf16* Vt = (LAS bf16*)(buf + AT_VOFF);
    const int key = C.tid & 63, part = C.tid >> 6;
    float kf[8], vf[8];
    if (f32src) {
#pragma unroll
        for (int e = 0; e < 4; ++e) { kf[e] = __uint_as_float(R.a[e]); kf[4 + e] = __uint_as_float(R.b[e]); vf[e] = __uint_as_float(R.c[e]); vf[4 + e] = __uint_as_float(R.d[e]); }
    } else {
#pragma unroll
        for (int e = 0; e < 4; ++e) { kf[2 * e] = bflo(R.a[e]); kf[2 * e + 1] = bfhi(R.a[e]); vf[2 * e] = bflo(R.b[e]); vf[2 * e + 1] = bfhi(R.b[e]); }
        if (rope) {
            const float* cp = ropec + (size_t)(tpos0 + key) * 32 + (part & 3) * 8; const f32x4 cs0 = *(const f32x4*)cp, cs1 = *(const f32x4*)(cp + 4), sn0 = *(const f32x4*)(cp + 65536), sn1 = *(const f32x4*)(cp + 65536 + 4);
#pragma unroll
            for (int e = 0; e < 8; ++e) { const float other = (e & 1) ? bfhi(R.c[e >> 1]) : bflo(R.c[e >> 1]); const float cs = (e < 4) ? cs0[e & 3] : cs1[e & 3], sn = (e < 4) ? sn0[e & 3] : sn1[e & 3];
                kf[e] = (part < 4) ? (kf[e] * cs - other * sn) : (other * sn + kf[e] * cs); }
        }
    }
    u32x4 w; w.x = pk2(kf[0], kf[1]); w.y = pk2(kf[2], kf[3]); w.z = pk2(kf[4], kf[5]); w.w = pk2(kf[6], kf[7]);
    *(LAS u32x4*)(Kc + key * AT_KS + part * 8) = w;
    const unsigned v01 = pk2(vf[0], vf[1]), v23 = pk2(vf[2], vf[3]), v45 = pk2(vf[4], vf[5]), v67 = pk2(vf[6], vf[7]);
    Vt[(part * 8 + 0) * AT_VS + key] = (bf16)v01; Vt[(part * 8 + 1) * AT_VS + key] = (bf16)(v01 >> 16); Vt[(part * 8 + 2) * AT_VS + key] = (bf16)v23; Vt[(part * 8 + 3) * AT_VS + key] = (bf16)(v23 >> 16);
    Vt[(part * 8 + 4) * AT_VS + key] = (bf16)v45; Vt[(part * 8 + 5) * AT_VS + key] = (bf16)(v45 >> 16); Vt[(part * 8 + 6) * AT_VS + key] = (bf16)v67; Vt[(part * 8 + 7) * AT_VS + key] = (bf16)(v67 >> 16);
}

__device__ __forceinline__ void attn_item3(const Ctx& C, int layer, bool latent, int b, int hk, int qblk) {
    const bf16* qkv = (const bf16*)(C.ws + WS_QKV);
    bf16* mix = (bf16*)(C.ws + WS_MIX);
    const float* ropec = (const float*)(C.ws + WS_ROPE);
    const int T = latent ? T_D : T_C, row_base = latent ? MC + b * T_D : b * T_C, q0 = qblk * 256;
    const int lane = C.lane, n = lane & 31, hh = lane >> 5, qw = q0 + C.wave * 32, qpos = qw + n;
    const float LOG2E = 1.4426950408889634f;
    float sink2[3];
#pragma unroll
    for (int g = 0; g < 3; ++g) sink2[g] = C.in[I_SINK][layer * AH + hk * 3 + g] * LOG2E;
    LAS unsigned char* qs_lds = C.lds + 2 * AT_BUF + C.wave * (3 * 4 * 1024) + lane * 16;
#pragma unroll
    for (int g = 0; g < 3; ++g) { const bf16* qp = qkv + (size_t)(row_base + qpos) * NQKV + (hk * 3 + g) * 64 + 8 * hh; float q[4][8];
#pragma unroll
      for (int ks = 0; ks < 4; ++ks) { const u32x4 a = *(const u32x4*)(qp + 16 * ks);
#pragma unroll
          for (int e = 0; e < 4; ++e) { q[ks][2 * e] = bflo(a[e]); q[ks][2 * e + 1] = bfhi(a[e]); } }
      if (latent) {
#pragma unroll
          for (int ks = 0; ks < 2; ++ks) { const float* cp = ropec + (size_t)qpos * 32 + 16 * ks + 8 * hh; const float* sp = cp + 65536;
#pragma unroll
              for (int e = 0; e < 8; ++e) { const float x1 = q[ks][e], x2 = q[ks + 2][e], cs = cp[e], sn = sp[e]; q[ks][e] = x1 * cs - x2 * sn; q[ks + 2][e] = x1 * sn + x2 * cs; } } }
      const float qs = 0.125f * LOG2E;
#pragma unroll
      for (int ks = 0; ks < 4; ++ks) { u32x4 w; w.x = pk2(q[ks][0] * qs, q[ks][1] * qs); w.y = pk2(q[ks][2] * qs, q[ks][3] * qs); w.z = pk2(q[ks][4] * qs, q[ks][5] * qs); w.w = pk2(q[ks][6] * qs, q[ks][7] * qs);
          *(LAS u32x4*)(qs_lds + (g * 4 + ks) * 1024) = w; } }
    f32x16 oacc[3][2]; float mrun[3], lrun[3];
#pragma unroll
    for (int g = 0; g < 3; ++g) { mrun[g] = sink2[g]; lrun[g] = 0.f;
#pragma unroll
        for (int i = 0; i < 16; ++i) { oacc[g][0][i] = 0.f; oacc[g][1][i] = 0.f; } }
    int nloc, kc0;
    if (latent) { const int lo = (q0 - 128 > 0) ? q0 - 128 : 0, hi = (q0 + 384 < T) ? q0 + 384 : T; kc0 = lo >> 6; nloc = (hi - lo) >> 6; } else { kc0 = 0; nloc = 4; }
    const int nch = nloc + (latent ? 8 : 0);
    AttnRegs R;
    auto chunk_src = [&](int ch, bool& f32src, const void*& kp, const void*& vp, int& ld, int& key0) {
        const bool loc = ch < nloc; key0 = loc ? (kc0 + ch) * 64 : (ch - nloc) * 64; f32src = !loc;
        if (loc) { const bf16* p = qkv + (size_t)(row_base + key0) * NQKV + 768 + hk * 64; kp = p; vp = p + 256; ld = NQKV; }
        else { const size_t off = (((size_t)b * DEPTH + layer) * PAST + key0) * KVW + hk * 64; kp = C.in[I_CK] + off; vp = C.in[I_CV] + off; ld = KVW; } };
    { bool f; const void* kp; const void* vp; int ld, k0; chunk_src(0, f, kp, vp, ld, k0); attn_load(C, R, f, kp, vp, ld, latent && !f, k0, ropec); }
    __syncthreads();
    for (int ch = 0; ch < nch; ++ch) {
        const bool loc = ch < nloc;
        const int key0 = loc ? (kc0 + ch) * 64 : (ch - nloc) * 64;
        LAS unsigned char* buf = C.lds + (ch & 1) * AT_BUF;
        attn_write(C, R, !loc, latent && loc, buf, key0, ropec);
        __syncthreads();
        if (ch + 1 < nch) { bool f; const void* kp; const void* vp; int ld, k0; chunk_src(ch + 1, f, kp, vp, ld, k0); attn_load(C, R, f, kp, vp, ld, latent && !f, k0, ropec); }
        LAS bf16* Kc = (LAS bf16*)(buf + AT_KOFF); LAS bf16* Vt = (LAS bf16*)(buf + AT_VOFF);
#pragma unroll 1
        for (int tt = 0; tt < 2; ++tt) {
            const int k0t = key0 + 32 * tt;
            if (loc && latent && (k0t + 31 < qw - 128 || k0t > qw + 31 + 128)) continue;
#pragma unroll
            for (int g = 0; g < 3; ++g) {
            __builtin_amdgcn_sched_barrier(0);
            f32x16 s;
#pragma unroll
            for (int i = 0; i < 16; ++i) s[i] = -mrun[g];
#pragma unroll
            for (int ks = 0; ks < 4; ++ks) { const bf16x8 kf = *(const LAS bf16x8*)(Kc + (32 * tt + n) * AT_KS + 16 * ks + 8 * hh); s = __builtin_amdgcn_mfma_f32_32x32x16_bf16(kf, *(const LAS bf16x8*)(qs_lds + (g * 4 + ks) * 1024), s, 0, 0, 0); }
            if (loc && latent && (k0t < qw - 97 || k0t > qw + 97)) {
#pragma unroll
                for (int i = 0; i < 16; ++i) { const int kpos = k0t + (i & 3) + 8 * (i >> 2) + 4 * hh; const int dlt = qpos - kpos; if (dlt > 128 || dlt < -128) s[i] = -1e30f; } }
            float mx = fmaxf(fmaxf(s[0], s[1]), s[2]);
#pragma unroll
            for (int i = 3; i < 15; i += 2) mx = fmaxf(fmaxf(mx, s[i]), s[i + 1]);
            mx = fmaxf(mx, s[15]);
            mx = fmaxf(mx, __shfl_xor(mx, 32));
            if (__builtin_amdgcn_ballot_w64(mx > 8.0f) != 0ull) {
                const float up = fmaxf(mx, 0.f), alpha = exp2f(-up);
                mrun[g] += up; lrun[g] *= alpha;
#pragma unroll
                for (int i = 0; i < 16; ++i) { oacc[g][0][i] *= alpha; oacc[g][1][i] *= alpha; s[i] -= up; }
            }
            float ps = 0.f;
#pragma unroll
            for (int i = 0; i < 16; ++i) { s[i] = __builtin_amdgcn_exp2f(s[i]); ps += s[i]; }
            lrun[g] += ps;
#pragma unroll
            for (int s2 = 0; s2 < 2; ++s2) {
                u32x4 pw; pw.x = pk2(s[8 * s2 + 0], s[8 * s2 + 1]); pw.y = pk2(s[8 * s2 + 2], s[8 * s2 + 3]); pw.z = pk2(s[8 * s2 + 4], s[8 * s2 + 5]); pw.w = pk2(s[8 * s2 + 6], s[8 * s2 + 7]);
                const bf16x8 pf = __builtin_bit_cast(bf16x8, pw);
#pragma unroll
                for (int mt = 0; mt < 2; ++mt) {
                    const LAS bf16* vp = Vt + (32 * mt + n) * AT_VS + 32 * tt + 16 * s2 + 4 * hh;
                    const u32x2 v0 = *(const LAS u32x2*)vp, v1 = *(const LAS u32x2*)(vp + 8);
                    u32x4 vw; vw.x = v0.x; vw.y = v0.y; vw.z = v1.x; vw.w = v1.y;
                    oacc[g][mt] = __builtin_amdgcn_mfma_f32_32x32x16_bf16(__builtin_bit_cast(bf16x8, vw), pf, oacc[g][mt], 0, 0, 0);
                }
            }
            }
        }
    }
#pragma unroll
    for (int g = 0; g < 3; ++g) {
    const float ltot = lrun[g] + __shfl_xor(lrun[g], 32) + exp2f(sink2[g] - mrun[g]), inv = 1.0f / ltot;
    bf16* op = mix + (size_t)(row_base + qpos) * D + 1280 + (hk * 3 + g) * 64;
#pragma unroll
    for (int mt = 0; mt < 2; ++mt)
#pragma unroll
        for (int gg = 0; gg < 4; ++gg) { u32x2 w; w.x = pk2(oacc[g][mt][4 * gg] * inv, oacc[g][mt][4 * gg + 1] * inv); w.y = pk2(oacc[g][mt][4 * gg + 2] * inv, oacc[g][mt][4 * gg + 3] * inv);
            *(u32x2*)(op + 32 * mt + 8 * gg + 4 * hh) = w; }
    }
}

template <int GRP>
__device__ __forceinline__ void hyena_item(const Ctx& C, int layer, int c) {
    constexpr int L = GRP ? 256 : 2048, NBt = GRP ? 32 : 8, NTAU = L / 64, NCOL = NTAU * NBt, NN = GRP ? 1 : 2;
    constexpr int CS = GRP ? 1088 : 8256;
    constexpr int ZOFF = 8 * 8256, ZS = 144, XOFF = ZOFF + (256 + 16) * ZS;
    constexpr int row_base = GRP ? 0 : MC;
    const bf16* hyt = (const bf16*)(C.ws + WS_HYT);
    bf16* hyo = (bf16*)(C.ws + WS_HYO);
    const int tid = C.tid, lane = C.lane, wave = C.wave;
    LAS unsigned char* FC = C.lds; LAS unsigned char* ZB = C.lds + ZOFF; LAS unsigned char* XB = C.lds + XOFF;
    const int i16 = lane & 15, kg = lane >> 4;
    __syncthreads();
    auto load_stream = [&](int stream, LAS unsigned char* dst, int pad) {
        const bf16* src = hyt + (size_t)(stream * 512 + c) * M + row_base;
        const float w0 = C.in[I_HSW][((size_t)layer * 3 + 0) * 1536 + stream * 512 + c], w1 = C.in[I_HSW][((size_t)layer * 3 + 1) * 1536 + stream * 512 + c], w2 = C.in[I_HSW][((size_t)layer * 3 + 2) * 1536 + stream * 512 + c];
        for (int task = tid; task < NBt * L / 8; task += 512) {
            const int b = task / (L / 8), t8 = (task % (L / 8)) * 8;
            const bf16* p = src + b * L + t8;
            const u32x4 a = *(const u32x4*)p; float x[10];
            x[0] = (t8 > 0) ? bf2f(p[-1]) : 0.f; x[9] = (t8 + 8 < L) ? bf2f(p[8]) : 0.f;
#pragma unroll
            for (int e = 0; e < 4; ++e) { x[1 + 2 * e] = bflo(a[e]); x[2 + 2 * e] = bfhi(a[e]); }
            float y[8];
#pragma unroll
            for (int e = 0; e < 8; ++e) y[e] = w0 * x[e] + w1 * x[e + 1] + w2 * x[e + 2];
            u32x4 w; w.x = pk2(y[0], y[1]); w.y = pk2(y[2], y[3]); w.z = pk2(y[4], y[5]); w.w = pk2(y[6], y[7]);
            const int col = (t8 >> 6) * NBt + b, j = t8 & 63;
            *(LAS u32x4*)(dst + (col + pad) * ZS + j * 2) = w;
        }
    };
    auto load_filter = [&](int o) {
        const bf16* g = (const bf16*)(C.ws + WS_FILT + (size_t)layer * FILT_LAYER + (GRP ? FILT_CTX_OFF : 0)) + (size_t)(o * 512 + c) * (2 * L);
        for (int ch = tid; ch < (2 * L + 16) / 8; ch += 512) { u32x4 w = (u32x4){0u, 0u, 0u, 0u}; if (ch < 2 * L / 8) w = *(const u32x4*)(g + ch * 8); *(LAS u32x4*)(FC + ch * 16) = w; }
        __syncthreads();
        LAS bf16* c0 = (LAS bf16*)FC;
        for (int task = tid; task < 7 * ((2 * L + 16) / 8); task += 512) { const int r = 1 + task / ((2 * L + 16) / 8), y8 = (task % ((2 * L + 16) / 8)) * 8; unsigned e[8];
#pragma unroll
            for (int jj = 0; jj < 8; ++jj) { const int y = y8 - r + jj; e[jj] = (y >= 0) ? (unsigned)c0[y] : 0u; }
            u32x4 w; w.x = e[0] | (e[1] << 16); w.y = e[2] | (e[3] << 16); w.z = e[4] | (e[5] << 16); w.w = e[6] | (e[7] << 16);
            *(LAS u32x4*)(FC + r * CS + y8 * 2) = w; }
    };
    for (int i = tid; i < 16 * 32; i += 512) { const int pc = i >> 5, q = i & 31; const int col = (pc < 8) ? pc : NCOL + pc; *(LAS unsigned*)(ZB + col * ZS + q * 4) = 0u; }
    load_stream(0, ZB, 8);
    load_stream(1, XB, 0);
    f32x4 acc[4][NN];
#pragma unroll
    for (int o = 0; o < 2; ++o) {
        load_filter(o);
        __syncthreads();
#pragma unroll
        for (int mi = 0; mi < 4; ++mi)
#pragma unroll
            for (int nn = 0; nn < NN; ++nn) acc[mi][nn] = (f32x4){0.f, 0.f, 0.f, 0.f};
        for (int db = -(NTAU - 1); db <= NTAU - 1; ++db) {
            bool val[NN]; bool any = false;
#pragma unroll
            for (int nn = 0; nn < NN; ++nn) { const int sc0 = 16 * (wave * NN + nn) - NBt * db; val[nn] = (sc0 + 15 >= 0) && (sc0 < NCOL); any |= val[nn]; }
            if (!any) continue;
            bf16x8 af[4][2];
#pragma unroll
            for (int mi = 0; mi < 4; ++mi)
#pragma unroll
                for (int ks = 0; ks < 2; ++ks) { const int y = L - 64 * db - 16 * mi - 8 * (i16 >> 3) + 32 * ks + 8 * kg; af[mi][ks] = *(const LAS bf16x8*)(FC + (i16 & 7) * CS + y * 2); }
#pragma unroll
            for (int nn = 0; nn < NN; ++nn) {
                if (!val[nn]) continue;
                const int col = 16 * (wave * NN + nn) + i16 - NBt * db + 8;
#pragma unroll
                for (int ks = 0; ks < 2; ++ks) { const bf16x8 bfr = *(const LAS bf16x8*)(ZB + col * ZS + (32 * ks + 8 * kg) * 2);
#pragma unroll
                    for (int mi = 0; mi < 4; ++mi) acc[mi][nn] = __builtin_amdgcn_mfma_f32_16x16x32_bf16(af[mi][ks], bfr, acc[mi][nn], 0, 0, 0); }
            }
        }
        __syncthreads();
        const float bias = C.in[I_HBIAS][((size_t)layer * 2 + o) * 512 + c];
#pragma unroll
        for (int nn = 0; nn < NN; ++nn) {
            const int col = 16 * (wave * NN + nn) + i16;
#pragma unroll
            for (int mi = 0; mi < 4; ++mi) { const int i0 = 16 * mi + 4 * kg;
                LAS u32x2* zp = (LAS u32x2*)(ZB + (col + 8) * ZS + i0 * 2); const u32x2 zv = *zp, xv = *(const LAS u32x2*)(XB + col * ZS + i0 * 2);
                const float z0 = bflo(zv.x), z1 = bfhi(zv.x), z2 = bflo(zv.y), z3 = bfhi(zv.y);
                const float r0 = bflo(xv.x) * (acc[mi][nn][0] + bias * z0), r1 = bfhi(xv.x) * (acc[mi][nn][1] + bias * z1), r2 = bflo(xv.y) * (acc[mi][nn][2] + bias * z2), r3 = bfhi(xv.y) * (acc[mi][nn][3] + bias * z3);
                u32x2 w; w.x = pk2(r0, r1); w.y = pk2(r2, r3);
                if (o == 0) *zp = w;
                else { const int tau = col / NBt, b = col % NBt; *(u32x2*)(hyo + (size_t)c * M + row_base + b * L + 64 * tau + i0) = w; } }
        }
        if (o == 0) { __syncthreads(); load_stream(2, XB, 0); }
    }
}

__device__ __forceinline__ void fin_phase(const Ctx& C, int layer) {
    const float* of = (const float*)(C.ws + WS_OF); const float* ob = (const float*)(C.ws + WS_OB); const float* bs = (const float*)(C.ws + WS_BS);
    const bf16* rkvg = (const bf16*)(C.ws + WS_RKVG); bf16* mix = (bf16*)(C.ws + WS_MIX);
    const int lane = C.lane;
    { const int hq = lane >> 4, c4 = (lane & 15) * 4;
    for (int task = C.bid * 8 + C.wave; task < M * 3; task += C.G * 8) {
        const int token = task / 3, h = (task % 3) * 4 + hq; const size_t oi = (size_t)token * RW + h * 64 + c4;
#if DBG_SKIP_RWKV
        *(u32x2*)(mix + (size_t)token * D + h * 64 + c4) = (u32x2){0u, 0u};
#else
        const f32x4 o = *(const f32x4*)(of + oi) + *(const f32x4*)(ob + oi);
        const float mu = row16_sum((o[0] + o[1]) + (o[2] + o[3])) * (1.0f / 64.0f);
        const f32x4 dd = o - mu;
        const float var = row16_sum((dd[0] * dd[0] + dd[1] * dd[1]) + (dd[2] * dd[2] + dd[3] * dd[3])) * (1.0f / 64.0f);
        const f32x4 lg = *(const f32x4*)(C.in[I_LNXG] + layer * RW + h * 64 + c4), lb = *(const f32x4*)(C.in[I_LNXB] + layer * RW + h * 64 + c4);
        const f32x4 on = dd * (lg * rsqrtf(var + GN_EPS)) + lb;
        const float bon = bs[(size_t)h * M + token] + bs[(size_t)(RH + h) * M + token];
        const u32x2 vw = *(const u32x2*)(rkvg + (size_t)token * 3072 + 1536 + h * 64 + c4), gw = *(const u32x2*)(rkvg + (size_t)token * 3072 + 2304 + h * 64 + c4);
        const float r0 = (on[0] + bon * bflo(vw.x)) * __builtin_amdgcn_rcpf(1.0f + __expf(-bflo(gw.x))), r1 = (on[1] + bon * bfhi(vw.x)) * __builtin_amdgcn_rcpf(1.0f + __expf(-bfhi(gw.x)));
        const float r2 = (on[2] + bon * bflo(vw.y)) * __builtin_amdgcn_rcpf(1.0f + __expf(-bflo(gw.y))), r3 = (on[3] + bon * bfhi(vw.y)) * __builtin_amdgcn_rcpf(1.0f + __expf(-bfhi(gw.y)));
        u32x2 w; w.x = pk2(r0, r1); w.y = pk2(r2, r3);
        *(u32x2*)(mix + (size_t)token * D + h * 64 + c4) = w;
#endif
    } }
    const bf16* hyo = (const bf16*)(C.ws + WS_HYO);
    LAS bf16* tile = (LAS bf16*)C.lds;
    for (int job = C.bid; job < 8 * (M / 64); job += C.G) {
        const int ct = job / (M / 64), tt = job % (M / 64), c0 = ct * 64, tok0 = tt * 64;
        __syncthreads();
        { const int c = C.tid >> 3, t8 = (C.tid & 7) * 8;
#if DBG_SKIP_HYENA
          const u32x4 w = (u32x4){0u, 0u, 0u, 0u};
#else
          const u32x4 w = *(const u32x4*)(hyo + (size_t)(c0 + c) * M + tok0 + t8);
#endif
          *(LAS u32x4*)(tile + c * 72 + t8) = w; }
        __syncthreads();
        { const int tok = C.tid >> 3, c8 = (C.tid & 7) * 8; unsigned e[8];
#pragma unroll
          for (int j = 0; j < 8; ++j) e[j] = tile[(c8 + j) * 72 + tok];
          u32x4 w; w.x = e[0] | (e[1] << 16); w.y = e[2] | (e[3] << 16); w.z = e[4] | (e[5] << 16); w.w = e[6] | (e[7] << 16);
          *(u32x4*)(mix + (size_t)(tok0 + tok) * D + 768 + c0 + c8) = w; }
    }
}

constexpr int S2_PT = 0, S2_RT = 2048, S2_QT = 4096, S2_KT = 6144, S2_QK = 8192, S2_VM = 12288, S2_A2T = 14336, S2_A34 = 14848, S2_TT = 15872, S2_GC = 16384, S2_A1F = 16640, S2_BON = 17664, S2_SLOT = 19712;
__device__ __forceinline__ float fast_sigmoid(float x) { return __builtin_amdgcn_rcpf(1.0f + __expf(-x)); }
__device__ __forceinline__ float wave64_sum(float x) { x = row16_sum(x); const int xi = __float_as_int(x);
    const float a = __int_as_float(__builtin_amdgcn_readlane(xi, 0)), b = __int_as_float(__builtin_amdgcn_readlane(xi, 16)), c = __int_as_float(__builtin_amdgcn_readlane(xi, 32)), d = __int_as_float(__builtin_amdgcn_readlane(xi, 48));
    return (a + b) + (c + d); }
__device__ __forceinline__ s16x4 pack4(const f32x4& v) { u32x2 w; w.x = pk2(v[0], v[1]); w.y = pk2(v[2], v[3]); return __builtin_bit_cast(s16x4, w); }
__device__ __forceinline__ bf16x8 pack8(const f32x4& a, const f32x4& b) { u32x4 w; w.x = pk2(a[0], a[1]); w.y = pk2(a[2], a[3]); w.z = pk2(b[0], b[1]); w.w = pk2(b[2], b[3]); return __builtin_bit_cast(bf16x8, w); }
__device__ __forceinline__ bf16x8 cat8(const s16x4& a, const s16x4& b) { bf16x8 r; r[0] = a[0]; r[1] = a[1]; r[2] = a[2]; r[3] = a[3]; r[4] = b[0]; r[5] = b[1]; r[6] = b[2]; r[7] = b[3]; return r; }

__device__ __forceinline__ void kknorm_phase(const Ctx& C, int layer) {
    const bf16* rkvg = (const bf16*)(C.ws + WS_RKVG); float* inv = (float*)(C.ws + WS_INV);
    for (int task = C.bid * 512 + C.tid; task < M * RH; task += C.G * 512) {
        const int token = task / RH, h = task % RH;
        const bf16* kp = rkvg + (size_t)token * 3072 + 768 + h * 64; const float* pk = C.in[I_KK] + layer * RW + h * 64;
        float ss = 0.f;
#pragma unroll
        for (int q = 0; q < 8; ++q) { const u32x4 a = *(const u32x4*)(kp + 8 * q); const f32x4 p0 = *(const f32x4*)(pk + 8 * q), p1 = *(const f32x4*)(pk + 8 * q + 4);
            const float x0 = bflo(a[0]) * p0[0], x1 = bfhi(a[0]) * p0[1], x2 = bflo(a[1]) * p0[2], x3 = bfhi(a[1]) * p0[3], x4 = bflo(a[2]) * p1[0], x5 = bfhi(a[2]) * p1[1], x6 = bflo(a[3]) * p1[2], x7 = bfhi(a[3]) * p1[3];
            ss += (x0 * x0 + x1 * x1) + (x2 * x2 + x3 * x3) + (x4 * x4 + x5 * x5) + (x6 * x6 + x7 * x7); }
        inv[task] = __builtin_amdgcn_rsqf(fmaxf(ss, 1e-24f));
    }
}

__device__ __forceinline__ void scan2_item(const Ctx& C, int layer, int item) {
    const int latent = item < 192; const int it2 = latent ? item : item - 192;
    const int b = it2 / 24, h = (it2 % 24) >> 1, d = it2 & 1;
    const int T = latent ? T_D : T_C, row_base = latent ? MC + b * T_D : b * T_C, nch = T / 16;
    const bf16* rkvg = (const bf16*)(C.ws + WS_RKVG); const bf16* lw = (const bf16*)(C.ws + WS_LW);
    float* obase = (float*)(C.ws + (d ? WS_OB : WS_OF)); float* bs = (float*)(C.ws + WS_BS); const float* invn = (const float*)(C.ws + WS_INV);
    const int lane = C.lane, wave = C.wave, c16 = lane & 15, quad = lane >> 4;
    __syncthreads();
    if (wave == 0) {
        f32x4 S[4][4];
        const size_t soff = ((((size_t)b * DEPTH + layer) * 2 + d) * RH + h) * 4096;
#pragma unroll
        for (int kt = 0; kt < 4; ++kt)
#pragma unroll
            for (int vt = 0; vt < 4; ++vt) S[kt][vt] = latent ? *(const f32x4*)(C.in[I_STATE] + soff + (16 * vt + c16) * 64 + 16 * kt + 4 * quad) : (f32x4){0.f, 0.f, 0.f, 0.f};
        for (int it = -6; it < nch; ++it) {
            if (it >= 0) {
                const LAS unsigned char* sl = C.lds + (it % 7) * S2_SLOT;
                bf16x8 sf[2][4];
#pragma unroll
                for (int ks = 0; ks < 2; ++ks)
#pragma unroll
                    for (int vt = 0; vt < 4; ++vt) sf[ks][vt] = pack8(S[2 * ks][vt], S[2 * ks + 1][vt]);
                const bf16x8 pt0 = *(const LAS bf16x8*)(sl + S2_PT + lane * 16), pt1 = *(const LAS bf16x8*)(sl + S2_PT + (64 + lane) * 16);
                const bf16x8 rt0 = *(const LAS bf16x8*)(sl + S2_RT + lane * 16), rt1 = *(const LAS bf16x8*)(sl + S2_RT + (64 + lane) * 16);
                const s16x4 a2t = *(const LAS s16x4*)(sl + S2_A2T + lane * 8), tt = *(const LAS s16x4*)(sl + S2_TT + lane * 8);
                const bf16x8 a34 = *(const LAS bf16x8*)(sl + S2_A34 + lane * 16);
                f32x4 O[4]; bf16x8 uv[4]; const s16x4 z4 = (s16x4){0, 0, 0, 0};
#pragma unroll
                for (int vt = 0; vt < 4; ++vt) {
                    const s16x4 vm = *(const LAS s16x4*)(sl + S2_VM + (vt * 64 + lane) * 8);
                    f32x4 w = (f32x4){0.f, 0.f, 0.f, 0.f}, o = w;
                    w = __builtin_amdgcn_mfma_f32_16x16x32_bf16(pt0, sf[0][vt], w, 0, 0, 0);
                    w = __builtin_amdgcn_mfma_f32_16x16x32_bf16(pt1, sf[1][vt], w, 0, 0, 0);
                    w = __builtin_amdgcn_mfma_f32_16x16x32_bf16(cat8(a2t, z4), cat8(vm, z4), w, 0, 0, 0);
                    o = __builtin_amdgcn_mfma_f32_16x16x32_bf16(rt0, sf[0][vt], o, 0, 0, 0);
                    o = __builtin_amdgcn_mfma_f32_16x16x32_bf16(rt1, sf[1][vt], o, 0, 0, 0);
                    f32x4 u = (f32x4){0.f, 0.f, 0.f, 0.f};
                    u = __builtin_amdgcn_mfma_f32_16x16x32_bf16(cat8(tt, z4), cat8(pack4(w), z4), u, 0, 0, 0);
                    uv[vt] = cat8(pack4(u), vm);
                    O[vt] = __builtin_amdgcn_mfma_f32_16x16x32_bf16(a34, uv[vt], o, 0, 0, 0);
                }
#pragma unroll
                for (int kt = 0; kt < 4; ++kt) {
                    const bf16x8 qk = *(const LAS bf16x8*)(sl + S2_QK + (kt * 64 + lane) * 16);
                    const f32x4 g4 = *(const LAS f32x4*)(sl + S2_GC + (16 * kt + 4 * quad) * 4);
#pragma unroll
                    for (int vt = 0; vt < 4; ++vt) S[kt][vt] = __builtin_amdgcn_mfma_f32_16x16x32_bf16(qk, uv[vt], S[kt][vt], 0, 0, 0) * g4;
                }
#pragma unroll
                for (int rg = 0; rg < 4; ++rg) { const int step = it * 16 + 4 * quad + rg, t = d ? (T - 1 - step) : step; float* op = obase + (size_t)(row_base + t) * RW + h * 64 + c16;
#pragma unroll
                    for (int vt = 0; vt < 4; ++vt) op[16 * vt] = O[vt][rg]; }
            }
            __syncthreads();
        }
        if (!latent) {
#pragma unroll
            for (int kt = 0; kt < 4; ++kt)
#pragma unroll
                for (int vt = 0; vt < 4; ++vt) *(f32x4*)(C.out + O_STATE + soff + (16 * vt + c16) * 64 + 16 * kt + 4 * quad) = S[kt][vt];
        }
    } else {
        const int j = wave - 1, k = lane, pc = h * 64 + k;
        LAS unsigned char* sl = C.lds + j * S2_SLOT;
        const float pw0 = C.in[I_W0][(layer * 2 + d) * RW + pc], pa0 = C.in[I_A0][(layer * 2 + d) * RW + pc];
        const float pkk = C.in[I_KK][layer * RW + pc], pka = C.in[I_KA][layer * RW + pc], prk = C.in[I_RK][layer * RW + pc];
        const int ks_ = k >> 5, kk5 = k & 31, tl_lane = ((kk5 >> 2) & 3) * 16, tl_j = ((kk5 >> 4) << 2) | (kk5 & 3);
        const int qk_base = ((k >> 4) * 64 + (k & 15)) * 8;
        const int vm_base = ((k >> 4) * 64 + (k & 15)) * 4;
        float L = 0.f, Gprev = 1.f;
        unsigned short xr[4], xk[4], xv[4], xw[4], xa[4]; float xi[4];
#pragma unroll
        for (int ii = 0; ii < 4; ++ii) { xr[ii] = 0; xk[ii] = 0; xv[ii] = 0; xw[ii] = 0; xa[ii] = 0; xi[ii] = 0.f; }
        auto issue = [&](int itn) {
            int phn = (itn + 6 - j) % 7; if (phn < 0) phn += 7;
            const int cn = itn + 6 - phn;
            if (phn < 4 && cn >= 0 && cn < nch) {
#pragma unroll
                for (int ii = 0; ii < 4; ++ii) { const int step = cn * 16 + phn * 4 + ii, t = d ? (T - 1 - step) : step; const size_t row = (size_t)(row_base + t);
                    const bf16* rp = rkvg + row * 3072 + pc; xr[ii] = rp[0]; xk[ii] = rp[768]; xv[ii] = rp[1536];
                    const bf16* lp = lw + row * 3072 + d * 768 + pc; xw[ii] = lp[0]; xa[ii] = lp[1536]; xi[ii] = invn[row * RH + h]; }
            }
        };
        issue(-6);
        for (int it = -6; it < nch; ++it) {
            int ph = (it + 6 - j) % 7; if (ph < 0) ph += 7;
            const int c = it + 6 - ph;
            if (ph < 6 && c >= 0 && c < nch) {
                if (ph < 4) {
                    if (ph == 0) { L = 0.f; Gprev = 1.f; }
                    unsigned short yr[4], yk[4], yv[4], yw[4], ya[4]; float yi[4];
#pragma unroll
                    for (int ii = 0; ii < 4; ++ii) { yr[ii] = xr[ii]; yk[ii] = xk[ii]; yv[ii] = xv[ii]; yw[ii] = xw[ii]; ya[ii] = xa[ii]; yi[ii] = xi[ii]; }
                    issue(it + 1);
#pragma unroll
                    for (int ii = 0; ii < 4; ++ii) {
                        const int i = ph * 4 + ii, step = c * 16 + i, t = d ? (T - 1 - step) : step;
                        const float r = bf2f(yr[ii]), kx = bf2f(yk[ii]);
                        const float kk = kx * pkk * yi[ii];
                        const float e = 0.6065306597126334f * fast_sigmoid(pw0 + bf2f(yw[ii]));
                        L -= e;
                        const float Gp = Gprev, G = __expf(L), Gi = __builtin_amdgcn_rcpf(G); Gprev = G;
                        const float a = fast_sigmoid(pa0 + bf2f(ya[ii]));
                        const float q = kk * a, kd = kx * (1.0f + (a - 1.0f) * pka);
                        ((LAS bf16*)(sl + S2_BON))[i * 64 + k] = (bf16)f2bf(r * kd * prk);
                        const int ti = (ks_ * 64 + tl_lane + i) * 8 + tl_j;
                        const unsigned pr = pk2(-kk * Gp, r * G), qkp = pk2(q * Gi, kd * Gi);
                        ((LAS bf16*)(sl + S2_PT))[ti] = (bf16)pr;
                        ((LAS bf16*)(sl + S2_RT))[ti] = (bf16)(pr >> 16);
                        const unsigned qb = qkp & 0xffffu, kb = qkp >> 16;
                        ((LAS bf16*)(sl + S2_QT))[ti] = (bf16)qb;
                        ((LAS bf16*)(sl + S2_KT))[ti] = (bf16)kb;
                        const int qi = qk_base + (i >> 2) * 128 + (i & 3);
                        ((LAS bf16*)(sl + S2_QK))[qi] = (bf16)qb; ((LAS bf16*)(sl + S2_QK))[qi + 4] = (bf16)kb;
                        ((LAS bf16*)(sl + S2_VM))[vm_base + (i >> 2) * 64 + (i & 3)] = yv[ii];
                        if (i == 15) ((LAS float*)(sl + S2_GC))[k] = G;
                    }
                } else if (ph == 4) {
                    issue(it + 1);
                    { const int sb = lane >> 2, g = lane & 3; const u32x4 b0 = *(const LAS u32x4*)(sl + S2_BON + (sb * 64 + g * 16) * 2), b1 = *(const LAS u32x4*)(sl + S2_BON + (sb * 64 + g * 16 + 8) * 2);
                      float bsum = ((bflo(b0[0]) + bfhi(b0[0])) + (bflo(b0[1]) + bfhi(b0[1]))) + ((bflo(b0[2]) + bfhi(b0[2])) + (bflo(b0[3]) + bfhi(b0[3])));
                      bsum += ((bflo(b1[0]) + bfhi(b1[0])) + (bflo(b1[1]) + bfhi(b1[1]))) + ((bflo(b1[2]) + bfhi(b1[2])) + (bflo(b1[3]) + bfhi(b1[3])));
                      bsum += dpp_f<0xB1>(bsum); bsum += dpp_f<0x4E>(bsum);
                      if (g == 0) { const int step = c * 16 + sb, t = d ? (T - 1 - step) : step; bs[(size_t)(d * RH + h) * M + (row_base + t)] = bsum; } }
                    f32x4 a1 = (f32x4){0.f, 0.f, 0.f, 0.f}, a2 = a1, a3 = a1, a4 = a1;
#pragma unroll
                    for (int ks = 0; ks < 2; ++ks) {
                        const bf16x8 fq = *(const LAS bf16x8*)(sl + S2_QT + (ks * 64 + lane) * 16), fk = *(const LAS bf16x8*)(sl + S2_KT + (ks * 64 + lane) * 16);
                        const bf16x8 fp = *(const LAS bf16x8*)(sl + S2_PT + (ks * 64 + lane) * 16), fr = *(const LAS bf16x8*)(sl + S2_RT + (ks * 64 + lane) * 16);
                        a1 = __builtin_amdgcn_mfma_f32_16x16x32_bf16(fq, fp, a1, 0, 0, 0); a2 = __builtin_amdgcn_mfma_f32_16x16x32_bf16(fk, fp, a2, 0, 0, 0);
                        a3 = __builtin_amdgcn_mfma_f32_16x16x32_bf16(fq, fr, a3, 0, 0, 0); a4 = __builtin_amdgcn_mfma_f32_16x16x32_bf16(fk, fr, a4, 0, 0, 0);
                    }
#pragma unroll
                    for (int rg = 0; rg < 4; ++rg) { const int s = 4 * quad + rg; const bool lt = s < c16, le = s <= c16;
                        a1[rg] = lt ? a1[rg] : 0.f; a2[rg] = lt ? a2[rg] : 0.f; a3[rg] = le ? a3[rg] : 0.f; a4[rg] = le ? a4[rg] : 0.f;
                    }
                    *(LAS f32x4*)(sl + S2_A1F + (c16 * 16 + 4 * quad) * 4) = a1;
                    *(LAS s16x4*)(sl + S2_A2T + lane * 8) = pack4(a2);
                    *(LAS bf16x8*)(sl + S2_A34 + lane * 16) = pack8(a3, a4);
                } else {
                    issue(it + 1);
                    float tr[16];
#pragma unroll
                    for (int tb = 0; tb < 4; ++tb) {
                        f32x4 col[4][4];
#pragma unroll
                        for (int t4 = 0; t4 < 4; ++t4)
#pragma unroll
                            for (int q = 0; q <= tb; ++q) col[t4][q] = *(const LAS f32x4*)(sl + S2_A1F + ((4 * tb + t4) * 16 + 4 * q) * 4);
#pragma unroll
                        for (int t4 = 0; t4 < 4; ++t4) { const int t = 4 * tb + t4; float acc = (lane == t) ? 1.0f : 0.f;
#pragma unroll
                            for (int jj = 0; jj < t; ++jj) acc += tr[jj] * col[t4][jj >> 2][jj & 3];
                            tr[t] = acc; }
                    }
                    if (lane < 16) {
#pragma unroll
                        for (int t = 0; t < 16; ++t) ((LAS bf16*)(sl + S2_TT))[((lane >> 2) * 16 + t) * 4 + (lane & 3)] = (bf16)f2bf(tr[t]); }
                }
            } else issue(it + 1);
            __syncthreads();
        }
    }
}


__global__ void __launch_bounds__(512, 2) mega_fwd(Params P) {
    extern __shared__ __attribute__((aligned(16))) unsigned char lds_raw[];
#define MKCTX() Ctx C; { int tid_ = threadIdx.x; asm volatile("" : "+v"(tid_)); int z_ = 0; asm volatile("" : "+s"(z_)); \
    C.lds = (LAS unsigned char*)lds_raw + z_; C.tid = tid_; C.lane = tid_ & 63; C.wave = __builtin_amdgcn_readfirstlane(tid_ >> 6); C.G = gridDim.x; C.bid = blockIdx.x; \
    C.in = P.in + z_; C.out = P.out + z_; C.ws = P.ws + z_; C.ctl = (unsigned*)(P.ws + WS_CTL) + z_; } \
    unsigned char* ws = C.ws; const float* modall = (const float*)(ws + WS_MOD); float* Y = C.out + O_Y; float* X1 = (float*)(ws + WS_X1); bf16* Hb = (bf16*)(ws + WS_H); const float* modl = modall + (size_t)l * 9 * NMOD; \
    (void)Y; (void)X1; (void)Hb; (void)modl;
    volatile LAS unsigned* misc = (volatile LAS unsigned*)((LAS unsigned char*)lds_raw + LDS_MISC);
    if (threadIdx.x < 64) misc[threadIdx.x] = 0u;
    __syncthreads();
    (void)xcd_barrier_post((unsigned*)(P.ws + WS_CTL) + CW_BAR, misc);
#define GRID_BAR() do { XcdBarrier b_; { int zb_ = 0; asm volatile("" : "+s"(zb_)); b_.bar = (unsigned*)(P.ws + WS_CTL) + CW_BAR + zb_; } b_.x = xb_xcc_id(); b_.st = misc; xcd_barrier(b_); } while (0)

    { const int l = 0; { MKCTX(); for (int rep_ = 0; rep_ < REP_P0; ++rep_) p0_transposes(C); } { MKCTX(); p0_wl2(C); } { MKCTX(); for (int rep_ = 0; rep_ < REP_P0; ++rep_) p0_mod(C); } { MKCTX(); for (int rep_ = 0; rep_ < REP_P0; ++rep_) p0_filters(C); } { MKCTX(); p0_rope(C); }
      GRID_BAR();
      { MKCTX(); p0_h0(C); }
      GRID_BAR(); }

    for (int l = 0; l < DEPTH; ++l) {
        { MKCTX();
            pg8::Gemm g{Hb, (const bf16*)(ws + WS_WIN) + (size_t)l * N1 * D, M, N1, D}; pg8::StaticOrder S; S.init(M, N1, C.G, C.bid);
            pg8::Epi1 E{(bf16*)(ws + WS_RKVG), (bf16*)(ws + WS_QKV), (bf16*)(ws + WS_LH), (bf16*)(ws + WS_HYT), C.out + O_CK, C.out + O_CV, l, M};
            for (int rep_ = 0; rep_ < REP_GEMM; ++rep_) pg8::gemm_phase<pg8::Epi1, pg8::StaticOrder, false, true>(C.lds, g, S, E);
        }
        GRID_BAR();
        { MKCTX(); kknorm_phase(C, l); }
        { MKCTX();
            pg8::Gemm g{(const bf16*)(ws + WS_LH), (const bf16*)(ws + WS_WL2) + (size_t)l * 3072 * 256, M, 3072, 256}; pg8::StaticOrder S; S.init(M, 3072, C.G, C.bid);
            pg8::EpiPlain E{(bf16*)(ws + WS_LW), 3072};
            for (int rep_ = 0; rep_ < REP_GEMM; ++rep_) pg8::gemm_phase<pg8::EpiPlain, pg8::StaticOrder, false, true>(C.lds, g, S, E);
        }
        { MKCTX();
        for (;;) {
            const int it = queue_pop(C, l * 2 + 0);
            if (it >= 256 + 512 + 512 + 128) break;
            if (it < 256) {
#if !DBG_SKIP_ATTN
                for (int rep_ = 0; rep_ < REP_ATT; ++rep_) { const Ctx Ci = relaunder(C); attn_item3(Ci, l, true, it >> 5, (it >> 3) & 3, it & 7); }
#endif
            } else if (it < 768) {
#if !DBG_SKIP_HYENA
                for (int rep_ = 0; rep_ < REP_HY; ++rep_) { const Ctx Ci = relaunder(C); hyena_item<0>(Ci, l, it - 256); }
#endif
            } else if (it < 1280) {
#if !DBG_SKIP_HYENA
                for (int rep_ = 0; rep_ < REP_HY; ++rep_) { const Ctx Ci = relaunder(C); hyena_item<1>(Ci, l, it - 768); }
#endif
            } else { const int a = it - 1280;
#if !DBG_SKIP_ATTN
                for (int rep_ = 0; rep_ < REP_ATT; ++rep_) { const Ctx Ci = relaunder(C); attn_item3(Ci, l, false, a >> 2, a & 3, 0); }
#endif
            }
        } }
        GRID_BAR();
#if !DBG_SKIP_RWKV
        { MKCTX(); for (;;) { const int it = queue_pop(C, l * 2 + 1); if (it >= 960) break; for (int rep_ = 0; rep_ < REP_SCAN; ++rep_) scan2_item(C, l, it); } }
#endif
        GRID_BAR();
        { MKCTX(); for (int rep_ = 0; rep_ < REP_FIN; ++rep_) fin_phase(C, l);
#if DBG_SKIP_ATTN
        { bf16* mix = (bf16*)(ws + WS_MIX); for (int i = C.bid * 512 + C.tid; i < M * 96; i += C.G * 512) { const int row = i / 96, c8 = (i % 96) * 8; *(u32x4*)(mix + (size_t)row * D + 1280 + c8) = (u32x4){0u, 0u, 0u, 0u}; } }
#endif
        }
        GRID_BAR();
        { MKCTX();
            pg8::Gemm g{(const bf16*)(ws + WS_MIX), (const bf16*)(ws + WS_WOUT) + (size_t)l * D * D, M, D, D}; pg8::StaticOrder S; S.init(M, D, C.G, C.bid);
            pg8::EpiRes E{(l == 0) ? C.in[I_XP] : Y, (l == 0) ? C.in[I_XS] : Y, (l == 0) ? MC : M, modl + 2 * D, NMOD, X1, D, DN_ALPHA};
            for (int rep_ = 0; rep_ < REP_GEMM; ++rep_) pg8::gemm_phase<pg8::EpiRes, pg8::StaticOrder, true, true>(C.lds, g, S, E);
        }
        GRID_BAR();
        { MKCTX(); ln_phase(C, X1, C.in[I_LN1G] + l * D, C.in[I_LN1B] + l * D, modl, 3 * D, 4 * D, Hb); }
        GRID_BAR();
#if !DBG_SKIP_FFN
        { MKCTX();
            pg8::Gemm g{Hb, (const bf16*)(ws + WS_WUP) + (size_t)l * NUP * D, M, NUP, D}; pg8::StaticOrder S; S.init(M, NUP, C.G, C.bid);
            pg8::EpiGate E{(bf16*)(ws + WS_G), C.in[I_CONVW] + (size_t)l * 3 * NUP, (float*)(ws + WS_HALO), C.lds + 131072};
            for (int rep_ = 0; rep_ < REP_GEMM; ++rep_) pg8::gemm_phase<pg8::EpiGate, pg8::StaticOrder, true, true>(C.lds, g, S, E);
        }
        GRID_BAR();
        { MKCTX(); gate_fixup_phase(C, (const float*)(ws + WS_HALO), C.in[I_CONVW] + (size_t)l * 3 * NUP, (bf16*)(ws + WS_G)); }
        GRID_BAR();
#endif
        { MKCTX();
            pg8::Gemm g{(const bf16*)(ws + WS_G), (const bf16*)(ws + WS_WDN) + (size_t)l * D * DFF, M, D, DFF}; pg8::StaticOrder S; S.init(M, D, C.G, C.bid);
            pg8::EpiRes E{X1, X1, M, modl + 5 * D, NMOD, Y, D, DN_ALPHA};
            for (int rep_ = 0; rep_ < REP_GEMM; ++rep_) pg8::gemm_phase<pg8::EpiRes, pg8::StaticOrder, true, true>(C.lds, g, S, E);
        }
        GRID_BAR();
        { MKCTX(); ln_phase(C, Y, C.in[I_LN2G] + l * D, C.in[I_LN2B] + l * D, (l + 1 < DEPTH) ? modl + 9 * NMOD : nullptr, 0, D, Hb); }
        if (l + 1 < DEPTH) GRID_BAR();
    }
}

extern "C" void kernel_launch(void* const* d_in, const int* in_sizes, int n_in, void* d_out, int out_size, void* d_ws, size_t ws_size, hipStream_t stream) {
    static int grid = 0;
    if (grid == 0) {
        if (n_in != N_IN || ws_size < WS_END) { fprintf(stderr, "kernel_launch: unexpected n_in %d or ws_size %zu (< %zu)\n", n_in, ws_size, (size_t)WS_END); grid = -1; return; }
        int dev = 0, cus = 0, per_cu = 0;
        if (hipGetDevice(&dev) != hipSuccess || hipDeviceGetAttribute(&cus, hipDeviceAttributeMultiprocessorCount, dev) != hipSuccess) { grid = -1; return; }
        if (hipFuncSetAttribute((const void*)mega_fwd, hipFuncAttributeMaxDynamicSharedMemorySize, LDS_BYTES) != hipSuccess) { fprintf(stderr, "kernel_launch: hipFuncSetAttribute failed\n"); grid = -1; return; }
        if (hipOccupancyMaxActiveBlocksPerMultiprocessor(&per_cu, (const void*)mega_fwd, 512, LDS_BYTES) != hipSuccess || per_cu < 1) { fprintf(stderr, "kernel_launch: occupancy query says %d\n", per_cu); }
        (void)hipGetLastError();
        grid = cus;
    }
    if (grid < 0) return;
    (void)hipMemsetAsync((char*)d_ws + WS_CTL, 0, 1 * MiB, stream);
    Params p{};
    for (int i = 0; i < N_IN; ++i) p.in[i] = (const float*)d_in[i];
    p.out = (float*)d_out; p.ws = (unsigned char*)d_ws;
    hipLaunchKernelGGL(mega_fwd, dim3(grid), dim3(512), LDS_BYTES, stream, p);
}
```

```cpp
#include <hip/hip_runtime.h>
#include <cstdio>
#include <cstdint>

#ifndef DBG_SKIP_RWKV
#define DBG_SKIP_RWKV 0
#endif
#ifndef DBG_SKIP_HYENA
#define DBG_SKIP_HYENA 0
#endif
#ifndef DBG_SKIP_ATTN
#define DBG_SKIP_ATTN 0
#endif
#ifndef DBG_SKIP_FFN
#define DBG_SKIP_FFN 0
#endif

#ifndef WGM_A
#define WGM_A 4
#endif
#ifndef WGM_L
#define WGM_L 4
#endif
#ifndef WGM_E
#define WGM_E 4
#endif
#ifndef WGM_G
#define WGM_G 4
#endif
#ifndef WGM_I
#define WGM_I 4
#endif
#ifndef REP_GEMM
#define REP_GEMM 1
#endif
#ifndef REP_SCAN
#define REP_SCAN 1
#endif
#ifndef REP_HY
#define REP_HY 1
#endif
#ifndef REP_ATT
#define REP_ATT 1
#endif
#ifndef REP_FIN
#define REP_FIN 1
#endif
#ifndef REP_CG
#define REP_CG 1
#endif
#ifndef REP_P0
#define REP_P0 1
#endif
#define LAS __attribute__((address_space(3)))
typedef unsigned short bf16;
typedef short bf16x8 __attribute__((ext_vector_type(8)));
typedef short s16x4 __attribute__((ext_vector_type(4)));
typedef float f32x4 __attribute__((ext_vector_type(4)));
typedef float f32x2 __attribute__((ext_vector_type(2)));
typedef float f32x16 __attribute__((ext_vector_type(16)));
typedef unsigned u32x4 __attribute__((ext_vector_type(4)));
typedef unsigned u32x2 __attribute__((ext_vector_type(2)));
typedef __bf16 hwbf16x2 __attribute__((ext_vector_type(2)));

constexpr int D = 2048, NB_C = 32, T_C = 256, NB_D = 8, T_D = 2048, DEPTH = 4, PAST = 512;
constexpr int MC = NB_C * T_C, MD = NB_D * T_D, M = MC + MD;
constexpr int RW = 768, RH = 12, HD = 64, HW = 512, AW = 768, AH = 12, KVH = 4, KVW = 256;
constexpr int INW = 5888, N1 = 6144, DFF = 5504, NUP = 11008, NMOD = 12288;
constexpr int NQKV = 1280;
constexpr float LN_EPS = 1e-5f, GN_EPS = 64e-5f;
constexpr float DN_ALPHA = 1.681792830507429f;
enum { I_XP = 0, I_XS, I_C, I_STATE, I_CK, I_CV, I_CCTX, I_WMOD, I_BMOD, I_WIN, I_W0, I_W1, I_W2, I_A0, I_A1, I_A2, I_KK, I_KA, I_RK, I_LNXG, I_LNXB,
       I_HSW, I_FW1, I_FB1, I_FF1, I_FW2, I_FB2, I_FF2, I_FW3, I_HBIAS, I_SINK, I_WOUT, I_LN1G, I_LN1B, I_WUP, I_CONVW, I_WDN, I_LN2G, I_LN2B, N_IN };
constexpr size_t O_Y = 0, O_STATE = (size_t)M * D, O_CK = O_STATE + (size_t)NB_C * DEPTH * 2 * RH * 64 * 64, O_CV = O_CK + (size_t)NB_C * DEPTH * T_C * KVW;

constexpr size_t MiB = 1u << 20;
constexpr size_t WS_CTL = 0;
constexpr size_t WS_MOD = 1 * MiB;
constexpr size_t WS_ROPE = 3 * MiB;
constexpr size_t WS_FILT = 4 * MiB;
constexpr size_t FILT_LAYER = 9 * MiB, FILT_CTX_OFF = 8 * MiB;
constexpr size_t WS_WIN = 40 * MiB;
constexpr size_t WS_WOUT = WS_WIN + 96 * MiB;
constexpr size_t WS_WUP = WS_WOUT + 32 * MiB;
constexpr size_t WS_WDN = WS_WUP + 172 * MiB;
constexpr size_t WS_WL2 = WS_WDN + 86 * MiB;
constexpr size_t WS_X1 = WS_WL2 + 6 * MiB;
constexpr size_t WS_H = WS_X1 + 192 * MiB;
constexpr size_t WS_BIG = WS_H + 96 * MiB;
constexpr size_t WS_U = WS_BIG;
constexpr size_t WS_G = WS_BIG + 516 * MiB;
constexpr size_t WS_RKVG = WS_BIG;
constexpr size_t WS_QKV = WS_BIG + 144 * MiB;
constexpr size_t WS_LH = WS_BIG + 204 * MiB;
constexpr size_t WS_HYT = WS_BIG + 216 * MiB;
constexpr size_t WS_LW = WS_BIG + 288 * MiB;
constexpr size_t WS_MIX = WS_BIG + 432 * MiB;
constexpr size_t WS_OF = WS_BIG + 528 * MiB;
constexpr size_t WS_OB = WS_BIG + 600 * MiB;
constexpr size_t WS_HYO = WS_BIG + 672 * MiB;
constexpr size_t WS_BS = WS_BIG + 696 * MiB;
constexpr size_t WS_INV = WS_BIG + 700 * MiB;
constexpr size_t WS_HALO = WS_BIG + 774 * MiB;
constexpr size_t WS_END = WS_HALO + 18 * MiB;
static_assert(WS_END <= 1536 * MiB, "workspace");

constexpr int CW_BAR = 4096;
constexpr int CW_Q = 16384;

constexpr int LDS_BYTES = 147456;
constexpr int LDS_MISC = 147456 - 256;

__device__ __forceinline__ unsigned f2bf(float f) { unsigned u = __float_as_uint(f); return (u + 0x7fffu + ((u >> 16) & 1u)) >> 16; }
__device__ __forceinline__ float bf2f(unsigned b) { return __uint_as_float(b << 16); }
__device__ __forceinline__ unsigned pk2(float lo, float hi) { hwbf16x2 b = __builtin_convertvector((f32x2){lo, hi}, hwbf16x2); return __builtin_bit_cast(unsigned, b); }
__device__ __forceinline__ float bflo(unsigned w) { return __uint_as_float(w << 16); }
__device__ __forceinline__ float bfhi(unsigned w) { return __uint_as_float(w & 0xffff0000u); }
__device__ __forceinline__ float sigmoidf_(float x) { return 1.0f / (1.0f + __expf(-x)); }
__device__ __forceinline__ float siluf_(float x) { return x / (1.0f + __expf(-x)); }
#define VM_WAIT() asm volatile("s_waitcnt vmcnt(0)" ::: "memory")

namespace pg8 {
#define PG8_LAS __attribute__((address_space(3)))
typedef unsigned short bf16_t;
typedef short bf16x8 __attribute__((ext_vector_type(8)));
typedef float f32x4 __attribute__((ext_vector_type(4)));
typedef unsigned u32x4 __attribute__((ext_vector_type(4)));
constexpr int BM = 256, BK = 64, HALF = 128, HTB = HALF * BK * 2  , STAGE_BYTES = 8 * HTB, NXCD = 8, WGM = 8;

__host__ __device__ __forceinline__ int lds_byte(int r, int c) { const int st = (r >> 4) * 2 + (c >> 5), rr = r & 15, cc = c & 31, ob = rr * 64 + cc * 2; return st * 1024 + (ob ^ (((ob >> 9) & 1) << 5)); }
__host__ __device__ __forceinline__ void stage_rc(int b, int& R, int& C) { const int st = b / 1024, sb = b % 1024, swz = sb ^ (((sb >> 9) & 1) << 5); R = (st >> 1) * 16 + swz / 64; C = (st & 1) * 32 + (swz % 64) / 2; }
__host__ __device__ __forceinline__ int perm32(int rho) { const int n = rho >> 4, i = rho & 15; return 8 * (i >> 2) + 4 * n + (i & 3); }

struct Unit { int pm, pn; };
struct Gemm { const bf16_t* A; const bf16_t* Bt; int M, N, K; };

struct StaticOrder {
    int nM, nN, nwg, G, c, wgm;
    __host__ __device__ void init(int M, int N, int G_, int c_, int wgm_ = 4) { nM = M / BM; nN = N / BM; nwg = nM * nN; G = G_; c = c_; wgm = wgm_; }
    __host__ __device__ bool next(int i, Unit& u) const {
        const long L = (long)i * G + c; if (L >= nwg) return false;
        int wgid = (int)L; { const int q = nwg / NXCD, r = nwg % NXCD, xcd = wgid % NXCD, off = wgid / NXCD; wgid = (xcd < r ? xcd * (q + 1) : r * (q + 1) + (xcd - r) * q) + off; }
        const int nig = wgm * nN, gid = wgid / nig, fm = gid * wgm, gsz = (nM - fm) < wgm ? (nM - fm) : wgm;
        u.pm = fm + ((wgid % nig) % gsz); u.pn = (wgid % nig) / gsz; return true;
    }
    __device__ __forceinline__ void a_ready(const Unit&) const {}
    __device__ __forceinline__ void done(const Unit&) const {}
};

__device__ __forceinline__ unsigned cvt_pk_bf16(float lo, float hi) { unsigned r; asm volatile("v_cvt_pk_bf16_f32 %0, %1, %2" : "=v"(r) : "v"(lo), "v"(hi)); return r; }

struct EpiPlain {
    static constexpr bool PERM = true, AFTER_DRAIN = false;
    bf16_t* O; int ldc;
    __device__ __forceinline__ void operator()(const f32x4 (&acc)[2][2][4][2], const Unit& u, int wr, int wc, int fr, int fq) const {
        const int row0 = u.pm * BM + wr * 64 + fr, col0 = u.pn * BM + wc * 32 + 8 * fq;
#pragma unroll
        for (int ai = 0; ai < 2; ++ai)
#pragma unroll
            for (int m = 0; m < 4; ++m) { bf16_t* rowp = O + (size_t)(row0 + ai * HALF + m * 16) * ldc + col0;
#pragma unroll
                for (int bj = 0; bj < 2; ++bj) { const f32x4 v0 = acc[ai][bj][m][0], v1 = acc[ai][bj][m][1];
                    u32x4 w; w.x = cvt_pk_bf16(v0[0], v0[1]); w.y = cvt_pk_bf16(v0[2], v0[3]); w.z = cvt_pk_bf16(v1[0], v1[1]); w.w = cvt_pk_bf16(v1[2], v1[3]);
                    *(u32x4*)(rowp + bj * HALF) = w; } }
    }
};

struct Epi1 {
    static constexpr bool PERM = true, AFTER_DRAIN = false;
    bf16_t* rkvg; bf16_t* qkv; bf16_t* lh; bf16_t* hyt; float* ck; float* cv; int layer; int Mrows;
    __device__ __forceinline__ void operator()(const f32x4 (&acc)[2][2][4][2], const Unit& u, int wr, int wc, int fr, int fq) const {
        const int row0 = u.pm * BM + wr * 64 + fr, cw = wc * 32 + 8 * fq, pn = u.pn;
        if (pn >= 12 && pn < 18) {
            const int c0 = (pn - 12) * BM + cw;
#pragma unroll
            for (int ai = 0; ai < 2; ++ai)
#pragma unroll
                for (int m = 0; m < 4; ++m) { const int row = row0 + ai * HALF + m * 16;
#pragma unroll
                    for (int bj = 0; bj < 2; ++bj)
#pragma unroll
                        for (int n = 0; n < 2; ++n)
#pragma unroll
                            for (int e = 0; e < 4; ++e) {
                                const unsigned w = cvt_pk_bf16(acc[ai][bj][m][n][e], 0.f);
                                hyt[(size_t)(c0 + bj * HALF + 4 * n + e) * Mrows + row] = (bf16_t)w; } }
            return;
        }
        bf16_t* base; int ldc; int coff; bool th = false; float* fdst = nullptr;
        if (pn < 12) { base = rkvg; ldc = 3072; coff = pn * BM; }
        else if (pn < 21) { base = qkv; ldc = 1280; coff = (pn - 18) * BM; }
        else if (pn == 21) { base = qkv; ldc = 1280; coff = 768; fdst = ck; }
        else if (pn == 22) { base = qkv; ldc = 1280; coff = 1024; fdst = cv; }
        else { base = lh; ldc = 256; coff = 0; th = true; }
        if (u.pm >= 32) fdst = nullptr;
#pragma unroll
        for (int ai = 0; ai < 2; ++ai)
#pragma unroll
            for (int m = 0; m < 4; ++m) { const int row = row0 + ai * HALF + m * 16; bf16_t* rowp = base + (size_t)row * ldc + coff + cw;
#pragma unroll
                for (int bj = 0; bj < 2; ++bj) { f32x4 v0 = acc[ai][bj][m][0], v1 = acc[ai][bj][m][1];
                    if (th && bj == 0) {
#pragma unroll
                        for (int e = 0; e < 4; ++e) { v0[e] = tanhf(v0[e]); v1[e] = tanhf(v1[e]); } }
                    u32x4 w; w.x = cvt_pk_bf16(v0[0], v0[1]); w.y = cvt_pk_bf16(v0[2], v0[3]); w.z = cvt_pk_bf16(v1[0], v1[1]); w.w = cvt_pk_bf16(v1[2], v1[3]);
                    *(u32x4*)(rowp + bj * HALF) = w;
                    if (fdst) { float* fp = fdst + ((size_t)(u.pm * 4 + layer) * 256 + (row & 255)) * 256 + cw + bj * HALF; *(f32x4*)fp = v0; *(f32x4*)(fp + 4) = v1; } } }
    }
};


struct EpiGate {
    static constexpr bool PERM = true, AFTER_DRAIN = false;
    bf16_t* G; const float* cw; float* halo; PG8_LAS unsigned char* edge;
    template <int CTRL> static __device__ __forceinline__ float dpp(float x) { return __int_as_float(__builtin_amdgcn_update_dpp(0, __float_as_int(x), CTRL, 0xf, 0xf, false)); }
    __device__ __forceinline__ void operator()(const f32x4 (&acc)[2][2][4][2], const Unit& u, int wr, int wc, int fr, int fq) const {
        const int cw0 = wc * 32 + 8 * fq, j0 = u.pn * 128 + cw0;
        PG8_LAS float* E = (PG8_LAS float*)edge;
#pragma unroll
        for (int ai = 0; ai < 2; ++ai) { const int g4 = 2 * ai + wr;
            if (fr == 0) {
#pragma unroll
                for (int bj = 0; bj < 2; ++bj)
#pragma unroll
                    for (int n = 0; n < 2; ++n) *(PG8_LAS f32x4*)(E + (g4 * 2 + 0) * 256 + bj * HALF + cw0 + 4 * n) = acc[ai][bj][0][n]; }
            if (fr == 15) {
#pragma unroll
                for (int bj = 0; bj < 2; ++bj)
#pragma unroll
                    for (int n = 0; n < 2; ++n) *(PG8_LAS f32x4*)(E + (g4 * 2 + 1) * 256 + bj * HALF + cw0 + 4 * n) = acc[ai][bj][3][n]; }
        }
        if (wr == 0 && fr < 2) { float* hp = halo + ((size_t)u.pm * 4 + fr) * 11008 + j0;
#pragma unroll
            for (int n = 0; n < 2; ++n) { *(f32x4*)(hp + 4 * n) = acc[0][0][0][n]; *(f32x4*)(hp + 5504 + 4 * n) = acc[0][1][0][n]; } }
        if (wr == 1 && fr >= 14) { float* hp = halo + ((size_t)u.pm * 4 + 2 + (fr - 14)) * 11008 + j0;
#pragma unroll
            for (int n = 0; n < 2; ++n) { *(f32x4*)(hp + 4 * n) = acc[1][0][3][n]; *(f32x4*)(hp + 5504 + 4 * n) = acc[1][1][3][n]; } }
        asm volatile("s_waitcnt lgkmcnt(0)" ::: "memory"); __builtin_amdgcn_s_barrier(); asm volatile("" ::: "memory");
        const int row0 = u.pm * BM + wr * 64 + fr;
#pragma unroll
        for (int ai = 0; ai < 2; ++ai) { const int g4 = 2 * ai + wr;
#pragma unroll
            for (int n = 0; n < 2; ++n) {
                f32x4 ca[4];
                { f32x4 w[3];
#pragma unroll
                  for (int tp = 0; tp < 3; ++tp) w[tp] = *(const f32x4*)(cw + tp * 11008 + j0 + 4 * n);
                  f32x4 pe = (f32x4){0.f, 0.f, 0.f, 0.f}, ne = pe;
                  if (g4 > 0) pe = *(const PG8_LAS f32x4*)(E + ((g4 - 1) * 2 + 1) * 256 + cw0 + 4 * n);
                  if (g4 < 3) ne = *(const PG8_LAS f32x4*)(E + ((g4 + 1) * 2 + 0) * 256 + cw0 + 4 * n);
#pragma unroll
                  for (int m = 0; m < 4; ++m) { const f32x4 v = acc[ai][0][m][n], vp = (m > 0) ? acc[ai][0][m - 1][n] : pe, vn = (m < 3) ? acc[ai][0][m + 1][n] : ne;
#pragma unroll
                      for (int e = 0; e < 4; ++e) { const float prev = dpp<0x121>((fr == 15) ? vp[e] : v[e]), next = dpp<0x12F>((fr == 0) ? vn[e] : v[e]); ca[m][e] = w[0][e] * prev + w[1][e] * v[e] + w[2][e] * next; } } }
                { f32x4 w[3];
#pragma unroll
                  for (int tp = 0; tp < 3; ++tp) w[tp] = *(const f32x4*)(cw + tp * 11008 + 5504 + j0 + 4 * n);
                  f32x4 pe = (f32x4){0.f, 0.f, 0.f, 0.f}, ne = pe;
                  if (g4 > 0) pe = *(const PG8_LAS f32x4*)(E + ((g4 - 1) * 2 + 1) * 256 + HALF + cw0 + 4 * n);
                  if (g4 < 3) ne = *(const PG8_LAS f32x4*)(E + ((g4 + 1) * 2 + 0) * 256 + HALF + cw0 + 4 * n);
#pragma unroll
                  for (int m = 0; m < 4; ++m) { const f32x4 v = acc[ai][1][m][n], vp = (m > 0) ? acc[ai][1][m - 1][n] : pe, vn = (m < 3) ? acc[ai][1][m + 1][n] : ne; float o[4];
#pragma unroll
                      for (int e = 0; e < 4; ++e) { const float prev = dpp<0x121>((fr == 15) ? vp[e] : v[e]), next = dpp<0x12F>((fr == 0) ? vn[e] : v[e]); const float cb = w[0][e] * prev + w[1][e] * v[e] + w[2][e] * next;
                          const float a = ca[m][e]; o[e] = a * __builtin_amdgcn_rcpf(1.0f + __expf(-a)) * cb; }
                      u32x2 wv; wv.x = cvt_pk_bf16(o[0], o[1]); wv.y = cvt_pk_bf16(o[2], o[3]);
                      *(u32x2*)(G + (size_t)(row0 + ai * HALF + m * 16) * 5504 + j0 + 4 * n) = wv; } }
            }
        }
    }
};

struct EpiRes {
    static constexpr bool PERM = false, AFTER_DRAIN = false;
    const float* xa; const float* xb; int nrows_a; const float* gate;   int gstride; float* dst; int ldc; float alpha;
    __device__ __forceinline__ void operator()(const f32x4 (&acc)[2][2][4][2], const Unit& u, int wr, int wc, int fr, int fq) const {
        const int row0 = u.pm * BM + wr * 64 + fr, col0 = u.pn * BM + wc * 32 + 4 * fq;
        const int bi = (u.pm < 32) ? 8 : ((u.pm - 32) >> 3);
        const float* gp = gate + (size_t)bi * gstride + col0;
        f32x4 gv[2][2];
#pragma unroll
        for (int bj = 0; bj < 2; ++bj)
#pragma unroll
            for (int n = 0; n < 2; ++n) gv[bj][n] = *(const f32x4*)(gp + bj * HALF + n * 16);
#pragma unroll
        for (int ai = 0; ai < 2; ++ai)
#pragma unroll
            for (int m = 0; m < 4; ++m) { const int row = row0 + ai * HALF + m * 16;
                const float* xp = (row < nrows_a ? xa + (size_t)row * ldc : xb + (size_t)(row - nrows_a) * ldc) + col0; float* dp = dst + (size_t)row * ldc + col0;
#pragma unroll
                for (int bj = 0; bj < 2; ++bj)
#pragma unroll
                    for (int n = 0; n < 2; ++n) { const f32x4 xv = *(const f32x4*)(xp + bj * HALF + n * 16);
                        *(f32x4*)(dp + bj * HALF + n * 16) = xv * alpha + gv[bj][n] * acc[ai][bj][m][n]; } }
    }
};

template <class Epi, class Sched, bool ALIGN_EPI = false, bool SP2 = false>
__device__ __forceinline__ void gemm_phase(PG8_LAS unsigned char* lds, const Gemm g, const Sched& S, const Epi& E) {
    int tid = threadIdx.x; asm volatile("" : "+v"(tid)); const int wid = __builtin_amdgcn_readfirstlane(tid >> 6), lane = tid & 63, wr = wid >> 2, wc = wid & 3, fr = lane & 15, fq = lane >> 4;
    const int K = g.K, nt = K / BK;
    unsigned voffA[2], voffB[2];
#pragma unroll
    for (int i = 0; i < 2; ++i) { int R, C; stage_rc(tid * 16 + i * 8192, R, C); const int Rb = Epi::PERM ? ((R & ~31) + perm32(R & 31)) : R;
        voffA[i] = (unsigned)(R * K + C) * 2u; voffB[i] = (unsigned)(Rb * K + C) * 2u; }
    const size_t kstep = (size_t)(BK * 2);
    const size_t hstep = (size_t)HALF * K * 2;
    const size_t tstep = 2 * hstep;
    const unsigned ldsw = (unsigned)wid * 1024u;
    const int aoff = lds_byte(wr * 64 + fr, fq * 8), boff = lds_byte(wc * 32 + fr, fq * 8);
#define PG8_SA(b, h) (((b) * 2 + (h)) * HTB)
#define PG8_SB(b, h) ((4 + (b) * 2 + (h)) * HTB)
#define PG8_STAGE(bufoff, gbase, voff) do { _Pragma("unroll") for (int _i = 0; _i < 2; ++_i) \
        __builtin_amdgcn_global_load_lds((const unsigned*)((const char*)(gbase) + (voff)[_i]), (PG8_LAS unsigned*)(lds + (bufoff) + ldsw + _i * 8192), 16, 0, 0); } while (0)
#define PG8_LDA(dst, b, h) do { _Pragma("unroll") for (int m = 0; m < 4; ++m) _Pragma("unroll") for (int k = 0; k < 2; ++k) dst[m][k] = *(const PG8_LAS bf16x8*)(lds + PG8_SA(b, h) + aoff + m * 2048 + k * 1024); } while (0)
#define PG8_LDB(dst, b, h) do { _Pragma("unroll") for (int n = 0; n < 2; ++n) _Pragma("unroll") for (int k = 0; k < 2; ++k) dst[n][k] = *(const PG8_LAS bf16x8*)(lds + PG8_SB(b, h) + boff + n * 2048 + k * 1024); } while (0)
#define PG8_MMA(ai, bj, At, Bt) do { __builtin_amdgcn_s_setprio(1); _Pragma("unroll") for (int m = 0; m < 4; ++m) _Pragma("unroll") for (int n = 0; n < 2; ++n) _Pragma("unroll") for (int k = 0; k < 2; ++k) \
        acc[ai][bj][m][n] = __builtin_amdgcn_mfma_f32_16x16x32_bf16(Bt[n][k], At[m][k], acc[ai][bj][m][n], 0, 0, 0); __builtin_amdgcn_s_setprio(0); } while (0)
#define PG8_WAIT_V(n) asm volatile("s_waitcnt vmcnt(" #n ")" ::: "memory")
#define PG8_WAIT_L(n) asm volatile("s_waitcnt lgkmcnt(" #n ")" ::: "memory")
#define PG8_BAR __builtin_amdgcn_s_barrier()
#define PG8_SCHED __builtin_amdgcn_sched_barrier(0)
    Unit cur, nxt; int ui = 0;
    if (!S.next(0, cur)) return;
    f32x4 acc[2][2][4][2];
#pragma unroll
    for (int a = 0; a < 2; ++a)
#pragma unroll
        for (int b = 0; b < 2; ++b)
#pragma unroll
            for (int m = 0; m < 4; ++m)
#pragma unroll
                for (int n = 0; n < 2; ++n) acc[a][b][m][n] = (f32x4){0.f, 0.f, 0.f, 0.f};
    bf16x8 At[4][2], B0[2][2], B1[2][2];
    const char* cA = (const char*)g.A + (size_t)cur.pm * tstep; const char* cB = (const char*)g.Bt + (size_t)cur.pn * tstep;
    S.a_ready(cur);
    if constexpr (SP2) {
        PG8_STAGE(PG8_SB(0, 0), cB, voffB); PG8_STAGE(PG8_SB(0, 1), cB + hstep, voffB); PG8_STAGE(PG8_SA(0, 0), cA, voffA); PG8_STAGE(PG8_SA(0, 1), cA + hstep, voffA);
        if (wr == 1) PG8_BAR;
        PG8_WAIT_V(2); PG8_BAR;
        PG8_STAGE(PG8_SB(1, 0), cB + kstep, voffB); PG8_STAGE(PG8_SA(1, 0), cA + kstep, voffA); PG8_STAGE(PG8_SB(1, 1), cB + hstep + kstep, voffB);
        PG8_WAIT_V(6); PG8_BAR;
    } else {
        PG8_STAGE(PG8_SB(0, 0), cB, voffB); PG8_STAGE(PG8_SA(0, 0), cA, voffA); PG8_STAGE(PG8_SB(0, 1), cB + hstep, voffB); PG8_STAGE(PG8_SA(0, 1), cA + hstep, voffA);
        if (wr == 1) PG8_BAR;
        PG8_WAIT_V(4); PG8_BAR;
        PG8_STAGE(PG8_SB(1, 0), cB + kstep, voffB); PG8_STAGE(PG8_SA(1, 0), cA + kstep, voffA); PG8_STAGE(PG8_SB(1, 1), cB + hstep + kstep, voffB);
        PG8_WAIT_V(6); PG8_BAR;
    }
    for (;;) {
        const bool has_next = S.next(ui + 1, nxt);
        const char* nA = has_next ? (const char*)g.A + (size_t)nxt.pm * tstep : cA; const char* nB = has_next ? (const char*)g.Bt + (size_t)nxt.pn * tstep : cB;
        for (int t = 0; t < nt; t += 2) {
            const bool last = (t == nt - 2);
            const char* a1 = cA + (size_t)(t + 1) * kstep;
            const char* a2 = last ? nA : cA + (size_t)(t + 2) * kstep; const char* b2 = last ? nB : cB + (size_t)(t + 2) * kstep;
            const char* a3 = a2 + kstep; const char* b3 = b2 + kstep;
            if (last && has_next) S.a_ready(nxt);
            if constexpr (SP2) {
            PG8_LDB(B0, 0, 0); PG8_LDB(B1, 0, 1); PG8_SCHED; PG8_LDA(At, 0, 0); PG8_STAGE(PG8_SA(1, 1), a1 + hstep, voffA);
            PG8_WAIT_V(8); PG8_WAIT_L(0); PG8_BAR; PG8_MMA(0, 0, At, B0); PG8_MMA(0, 1, At, B1); PG8_BAR; PG8_SCHED;
            PG8_LDA(At, 0, 1); PG8_STAGE(PG8_SB(0, 0), b2, voffB); PG8_STAGE(PG8_SB(0, 1), b2 + hstep, voffB); PG8_STAGE(PG8_SA(0, 0), a2, voffA);
            PG8_WAIT_V(8); PG8_WAIT_L(0); PG8_BAR; PG8_MMA(1, 0, At, B0); PG8_MMA(1, 1, At, B1); PG8_BAR; PG8_SCHED;
            PG8_LDB(B0, 1, 0); PG8_LDB(B1, 1, 1); PG8_SCHED; PG8_LDA(At, 1, 0); PG8_STAGE(PG8_SA(0, 1), a2 + hstep, voffA);
            PG8_WAIT_V(8); PG8_WAIT_L(0); PG8_BAR; PG8_MMA(0, 0, At, B0); PG8_MMA(0, 1, At, B1); PG8_BAR; PG8_SCHED;
            PG8_LDA(At, 1, 1); PG8_STAGE(PG8_SB(1, 0), b3, voffB); PG8_STAGE(PG8_SB(1, 1), b3 + hstep, voffB); PG8_STAGE(PG8_SA(1, 0), a3, voffA);
            PG8_WAIT_V(8); PG8_WAIT_L(0); PG8_BAR; PG8_MMA(1, 0, At, B0); PG8_MMA(1, 1, At, B1); PG8_BAR; PG8_SCHED;
            } else {
            PG8_LDB(B0, 0, 0); PG8_SCHED; PG8_LDA(At, 0, 0); PG8_STAGE(PG8_SA(1, 1), a1 + hstep, voffA);
            PG8_WAIT_L(8); PG8_BAR; PG8_WAIT_L(0); PG8_MMA(0, 0, At, B0); PG8_BAR; PG8_SCHED;
            PG8_LDB(B1, 0, 1); PG8_STAGE(PG8_SB(0, 0), b2, voffB);
            PG8_BAR; PG8_WAIT_L(0); PG8_MMA(0, 1, At, B1); PG8_BAR;
            PG8_LDA(At, 0, 1); PG8_STAGE(PG8_SA(0, 0), a2, voffA);
            PG8_BAR; PG8_WAIT_L(0); PG8_MMA(1, 0, At, B0); PG8_BAR; PG8_SCHED;
            PG8_STAGE(PG8_SB(0, 1), b2 + hstep, voffB);
            PG8_WAIT_V(6); PG8_BAR; PG8_MMA(1, 1, At, B1); PG8_BAR;
            PG8_LDB(B0, 1, 0); PG8_SCHED; PG8_LDA(At, 1, 0); PG8_STAGE(PG8_SA(0, 1), a2 + hstep, voffA);
            PG8_WAIT_L(8); PG8_BAR; PG8_WAIT_L(0); PG8_MMA(0, 0, At, B0); PG8_BAR; PG8_SCHED;
            PG8_LDB(B1, 1, 1); PG8_STAGE(PG8_SB(1, 0), b3, voffB);
            PG8_BAR; PG8_WAIT_L(0); PG8_MMA(0, 1, At, B1); PG8_BAR;
            PG8_LDA(At, 1, 1); PG8_STAGE(PG8_SA(1, 0), a3, voffA);
            PG8_BAR; PG8_WAIT_L(0); PG8_MMA(1, 0, At, B0); PG8_BAR; PG8_SCHED;
            PG8_STAGE(PG8_SB(1, 1), b3 + hstep, voffB);
            PG8_WAIT_V(6); PG8_BAR; PG8_MMA(1, 1, At, B1); PG8_BAR;
            }
        }
        if constexpr (ALIGN_EPI) { if (wr == 0) PG8_BAR; }
        if constexpr (!Epi::AFTER_DRAIN) { E(acc, cur, wr, wc, fr, fq); S.done(cur); }
        if (!has_next) break;
#pragma unroll
        for (int a = 0; a < 2; ++a)
#pragma unroll
            for (int b = 0; b < 2; ++b)
#pragma unroll
                for (int m = 0; m < 4; ++m)
#pragma unroll
                    for (int n = 0; n < 2; ++n) acc[a][b][m][n] = (f32x4){0.f, 0.f, 0.f, 0.f};
        cur = nxt; cA = nA; cB = nB; ++ui;
        if constexpr (ALIGN_EPI) { if (wr == 1) PG8_BAR; }
    }
    PG8_WAIT_V(0);
    if constexpr (!ALIGN_EPI) { if (wr == 0) PG8_BAR; }
    PG8_BAR;
    if constexpr (Epi::AFTER_DRAIN) { E.fused(acc, cur, wr, wc, fr, fq, lds, wid, lane); S.done(cur); }
#undef PG8_SA
#undef PG8_SB
#undef PG8_STAGE
#undef PG8_LDA
#undef PG8_LDB
#undef PG8_MMA
#undef PG8_WAIT_V
#undef PG8_WAIT_L
#undef PG8_BAR
#undef PG8_SCHED
}
}

#define XB_TMO      128
#define XB_XCNT(j)  (256  + 64 * (j))
#define XB_XSUB(j)  (1280 + 64 * (j))
#define XB_XGEN(j)  (2304 + 64 * (j))
#define XB_TOP      3328
#define XB_TOPGEN   3392
#define XCD_BAR_WORDS 3456
#define XB_SPIN_CAP (1u << 18)

__device__ __forceinline__ unsigned xb_ld(unsigned* p)              { return __hip_atomic_load(p, __ATOMIC_RELAXED, __HIP_MEMORY_SCOPE_AGENT); }
__device__ __forceinline__ unsigned xb_add(unsigned* p, unsigned v) { return __hip_atomic_fetch_add(p, v, __ATOMIC_RELAXED, __HIP_MEMORY_SCOPE_AGENT); }
__device__ __forceinline__ unsigned xb_xcc_id() { return (unsigned)__builtin_amdgcn_s_getreg((3 << 11) | 20) & 0xFu; }
#define XB_SPIN(cond, bar) do { unsigned _sp = 0; while (cond) { __builtin_amdgcn_s_sleep(1); \
    if ((++_sp & 255u) == 0u) { if (xb_ld(&(bar)[XB_TMO])) break; if (_sp > XB_SPIN_CAP) { atomicAdd(&(bar)[XB_TMO], 1u); break; } } } } while (0)

struct XcdBarrier {
    unsigned* bar; unsigned x;
    volatile LAS unsigned* st;
};

__device__ __forceinline__ XcdBarrier xcd_barrier_post(unsigned* bar, volatile LAS unsigned* st) {
    XcdBarrier b; b.bar = bar; b.x = xb_xcc_id(); b.st = st;
    if (threadIdx.x == 0) (void)xb_add(&bar[XB_XCNT(b.x)], 1u);
    return b;
}
__device__ __forceinline__ void xcd_barrier_complete(unsigned* bar, unsigned x, unsigned& nloc, unsigned& nx) {
    const unsigned G = gridDim.x * gridDim.y * gridDim.z;
    unsigned sum, cnt, mine, sp = 0u;
    for (;;) {
        sum = 0u; cnt = 0u; mine = 0u;
#pragma unroll
        for (unsigned j = 0; j < 16; ++j) { const unsigned c = xb_ld(&bar[XB_XCNT(j)]); sum += c; cnt += (c > 0u) ? 1u : 0u; mine = (j == x) ? c : mine; }
        if (sum == G) break;
        __builtin_amdgcn_s_sleep(1);
        if ((++sp & 255u) == 0u) { if (xb_ld(&bar[XB_TMO])) break; if (sp > XB_SPIN_CAP) { atomicAdd(&bar[XB_TMO], 1u); break; } }
    }
    nloc = mine > 0u ? mine : 1u; nx = cnt > 0u ? cnt : 1u;
}

__device__ __forceinline__ void xcd_barrier(const XcdBarrier& b) {
    asm volatile("s_waitcnt vmcnt(0)" ::: "memory");
    __syncthreads();
    if (threadIdx.x == 0) {
        unsigned* bar = b.bar;
        __builtin_amdgcn_s_waitcnt(0);
        unsigned nloc = b.st[0], nx = b.st[1];
        if (nloc == 0u) { xcd_barrier_complete(bar, b.x, nloc, nx); b.st[0] = nloc; b.st[1] = nx; }
        const unsigned old = xb_add(&bar[XB_XSUB(b.x)], 1u);
        const unsigned gen = old / nloc;
        if (old + 1u == (gen + 1u) * nloc) {
            __builtin_amdgcn_fence(__ATOMIC_RELEASE, "agent");
            asm volatile("s_waitcnt vmcnt(0)" ::: "memory");
            const unsigned og = xb_add(&bar[XB_TOP], 1u);
            const unsigned tg = og / nx;
            if (og + 1u == (tg + 1u) * nx) xb_add(&bar[XB_TOPGEN], 1u);
            else XB_SPIN(xb_ld(&bar[XB_TOPGEN]) == tg, bar);
            __builtin_amdgcn_fence(__ATOMIC_ACQUIRE, "agent");
            xb_add(&bar[XB_XGEN(b.x)], 1u);
            asm volatile("s_waitcnt vmcnt(0)" ::: "memory");
        } else {
            XB_SPIN(xb_ld(&bar[XB_XGEN(b.x)]) == gen, bar);
            __builtin_amdgcn_fence(__ATOMIC_ACQUIRE, "agent");
            asm volatile("s_waitcnt vmcnt(0)" ::: "memory");
        }
    }
    __syncthreads();
}


struct Params { const float* in[N_IN]; float* out; unsigned char* ws; };

struct Ctx {
    LAS unsigned char* lds; int tid, lane, wave, G, bid;
    const float* const* in; float* out; unsigned char* ws; unsigned* ctl;
};

__device__ __forceinline__ float wave_sum(float v) {
#pragma unroll
    for (int o = 32; o >= 1; o >>= 1) v += __shfl_xor(v, o);
    return v;
}
template <int CTRL> __device__ __forceinline__ float dpp_f(float x) { return __int_as_float(__builtin_amdgcn_update_dpp(0, __float_as_int(x), CTRL, 0xf, 0xf, false)); }
__device__ __forceinline__ float row16_sum(float x) { x += dpp_f<0x128>(x); x += dpp_f<0x124>(x); x += dpp_f<0x122>(x); x += dpp_f<0x121>(x); return x; }

__device__ __forceinline__ Ctx relaunder(const Ctx& C) { Ctx R = C; int t = C.tid; asm volatile("" : "+v"(t)); R.tid = t; R.lane = t & 63; R.wave = __builtin_amdgcn_readfirstlane(t >> 6); return R; }

__device__ __forceinline__ int queue_pop(const Ctx& C, int qid) {
    volatile LAS int* slot = (volatile LAS int*)(C.lds + LDS_MISC + 16);
    __syncthreads();
    if (C.tid == 0) *slot = (int)__hip_atomic_fetch_add(C.ctl + CW_Q + 64 * qid, 1u, __ATOMIC_RELAXED, __HIP_MEMORY_SCOPE_AGENT);
    __syncthreads();
    return *slot;
}

__device__ __forceinline__ void tr_decode(const Ctx& C, int job, const float*& src, int& ldsrc, bf16*& dst, int& lddst) {
    constexpr int TPL = 12352;
    const int l = job / TPL, ti = job % TPL;
    if (ti < 2944) { const int kt = ti / 92, nt = ti % 92; src = C.in[I_WIN] + (size_t)l * D * INW + (size_t)kt * 64 * INW + nt * 64; ldsrc = INW;
        dst = (bf16*)(C.ws + WS_WIN) + (size_t)l * N1 * D + (size_t)nt * 64 * D + kt * 64; lddst = D; }
    else if (ti < 3072) { const int t = ti - 2944, i = t >> 5, kt = t & 31; src = C.in[(i < 2) ? I_W1 : I_A1] + ((size_t)(l * 2 + (i & 1)) * D + kt * 64) * 64; ldsrc = 64;
        dst = (bf16*)(C.ws + WS_WIN) + (size_t)l * N1 * D + (size_t)(INW + 64 * i) * D + kt * 64; lddst = D; }
    else if (ti < 4096) { const int t = ti - 3072, kt = t >> 5, nt = t & 31; src = C.in[I_WOUT] + (size_t)l * D * D + (size_t)kt * 64 * D + nt * 64; ldsrc = D;
        dst = (bf16*)(C.ws + WS_WOUT) + (size_t)l * D * D + (size_t)nt * 64 * D + kt * 64; lddst = D; }
    else if (ti < 9600) { const int t = ti - 4096, kt = t / 172, nt = t % 172; src = C.in[I_WUP] + (size_t)l * D * NUP + (size_t)kt * 64 * NUP + nt * 64; ldsrc = NUP;
        const int c0 = nt * 64, cb = (c0 < DFF) ? c0 : c0 - DFF, r0 = (cb >> 7) * 256 + ((c0 < DFF) ? 0 : 128) + (cb & 127);
        dst = (bf16*)(C.ws + WS_WUP) + (size_t)l * NUP * D + (size_t)r0 * D + kt * 64; lddst = D; }
    else { const int t = ti - 9600, kt = t >> 5, nt = t & 31; src = C.in[I_WDN] + (size_t)l * DFF * D + (size_t)kt * 64 * D + nt * 64; ldsrc = D;
        dst = (bf16*)(C.ws + WS_WDN) + (size_t)l * D * DFF + (size_t)nt * 64 * DFF + kt * 64; lddst = DFF; }
}
__device__ __forceinline__ void p0_transposes(const Ctx& C) {
    constexpr int TPL = 12352, NT = DEPTH * TPL, TB = 8;
    LAS float* tiles = (LAS float*)C.lds;
    const int tid = C.tid;
    for (int jb = C.bid; jb * TB < NT; jb += C.G) {
        f32x4 v[TB][2];
#pragma unroll
        for (int q = 0; q < TB; ++q) { const int job = jb * TB + q; if (job < NT) { const float* src; int ldsrc; bf16* dst; int lddst; tr_decode(C, job, src, ldsrc, dst, lddst);
#pragma unroll
            for (int p = 0; p < 2; ++p) v[q][p] = *(const f32x4*)(src + (size_t)(p * 32 + (tid >> 4)) * ldsrc + (tid & 15) * 4); } }
        __syncthreads();
#pragma unroll
        for (int q = 0; q < TB; ++q) { LAS float* tile = tiles + q * (64 * 65);
#pragma unroll
            for (int p = 0; p < 2; ++p) { const int k = p * 32 + (tid >> 4), n4 = (tid & 15) * 4; tile[k * 65 + n4 + 0] = v[q][p][0]; tile[k * 65 + n4 + 1] = v[q][p][1]; tile[k * 65 + n4 + 2] = v[q][p][2]; tile[k * 65 + n4 + 3] = v[q][p][3]; } }
        __syncthreads();
#pragma unroll
        for (int q = 0; q < TB; ++q) { const int job = jb * TB + q; if (job < NT) { const float* src; int ldsrc; bf16* dst; int lddst; tr_decode(C, job, src, ldsrc, dst, lddst);
            const LAS float* tile = tiles + q * (64 * 65); const int n = tid >> 3, k8 = (tid & 7) * 8; float f[8];
#pragma unroll
            for (int j = 0; j < 8; ++j) f[j] = tile[(k8 + j) * 65 + n];
            u32x4 w; w.x = pk2(f[0], f[1]); w.y = pk2(f[2], f[3]); w.z = pk2(f[4], f[5]); w.w = pk2(f[6], f[7]);
            *(u32x4*)(dst + (size_t)n * lddst + k8) = w; } }
    }
    __syncthreads();
}

__device__ __forceinline__ void p0_wl2(const Ctx& C) {
    const int total = DEPTH * 3072 * 32;
    for (int idx = C.bid * 512 + C.tid; idx < total; idx += C.G * 512) {
        const int l = idx / (3072 * 32), rem = idx % (3072 * 32), n = rem >> 5, k8 = (rem & 31) * 8;
        const int blk = n / 768, j = n % 768, kb = k8 >> 6, kk0 = k8 & 63;
        u32x4 w = (u32x4){0u, 0u, 0u, 0u};
        if (kb == blk) { const float* s = C.in[(blk < 2) ? I_W2 : I_A2] + ((size_t)(l * 2 + (blk & 1)) * 64 + kk0) * 768 + j; float f[8];
#pragma unroll
            for (int e = 0; e < 8; ++e) f[e] = s[(size_t)e * 768];
            w.x = pk2(f[0], f[1]); w.y = pk2(f[2], f[3]); w.z = pk2(f[4], f[5]); w.w = pk2(f[6], f[7]); }
        *(u32x4*)((bf16*)(C.ws + WS_WL2) + ((size_t)l * 3072 + n) * 256 + k8) = w;
    }
}

__device__ __forceinline__ void p0_mod(const Ctx& C) {
    LAS float* sc = (LAS float*)C.lds;
    LAS float* red = (LAS float*)(C.lds + 9 * 2048 * 4);
    __syncthreads();
    for (int i = C.tid; i < 9 * 2048; i += 512) { const int bi = i >> 11, k = i & 2047; const float x = (bi < 8) ? C.in[I_C][bi * 2048 + k] : C.in[I_CCTX][k]; sc[i] = siluf_(x); }
    __syncthreads();
    const int cg = C.tid & 15, kg = C.tid >> 4;
    for (int unit = C.bid; unit < DEPTH * 192; unit += C.G) {
        const int l = unit / 192, cb = (unit % 192) * 64;
        f32x4 acc[9];
#pragma unroll
        for (int bi = 0; bi < 9; ++bi) acc[bi] = (f32x4){0.f, 0.f, 0.f, 0.f};
        const float* wp = C.in[I_WMOD] + ((size_t)l * D + kg * 64) * NMOD + cb + cg * 4;
#pragma unroll 8
        for (int kk = 0; kk < 64; ++kk) { const f32x4 w = *(const f32x4*)(wp + (size_t)kk * NMOD);
#pragma unroll
            for (int bi = 0; bi < 9; ++bi) acc[bi] += w * sc[bi * 2048 + kg * 64 + kk]; }
#pragma unroll
        for (int bi = 0; bi < 9; ++bi)
#pragma unroll
            for (int e = 0; e < 4; ++e) { float v = acc[bi][e]; v += __shfl_xor(v, 16); v += __shfl_xor(v, 32); if (C.lane < 16) red[(C.wave * 9 + bi) * 64 + cg * 4 + e] = v; }
        __syncthreads();
        for (int idx = C.tid; idx < 9 * 64; idx += 512) { const int bi = idx >> 6, c = idx & 63; float s = C.in[I_BMOD][l * NMOD + cb + c];
#pragma unroll
            for (int w = 0; w < 8; ++w) s += red[(w * 9 + bi) * 64 + c];
            ((float*)(C.ws + WS_MOD))[((size_t)l * 9 + bi) * NMOD + cb + c] = s; }
        __syncthreads();
    }
}

__device__ __forceinline__ void p0_filters(const Ctx& C) {
    LAS float* z = (LAS float*)C.lds;
    LAS float* h1 = z + 16 * 33;
    LAS float* h2 = h1 + 16 * 64;
    const float HY_MIN = -3.0701134573253945f, HY_MAX = -15.350567286626973f;
    for (int unit = C.bid; unit < DEPTH * 144; unit += C.G) {
        const int l = unit / 144, u2 = unit % 144, grp = (u2 < 128) ? 0 : 1, jb = grp ? (u2 - 128) : u2, L = grp ? 256 : 2048, j0 = jb * 16;
        __syncthreads();
        for (int idx = C.tid; idx < 16 * 33; idx += 512) { const int jj = idx / 33, e = idx % 33, j = j0 + jj; float v;
            if (e == 0) v = (float)j / (float)(L - 1);
            else { const int band = (e - 1) & 15; const float f = 1e-4f + (float)band * ((15.0f - 1e-4f) / 15.0f); const float ang = 6.283185307179586f * (float)j * f / (float)L; v = (e <= 16) ? cosf(ang) : sinf(ang); }
            z[idx] = v; }
        __syncthreads();
        for (int idx = C.tid; idx < 1024; idx += 512) { const int jj = idx >> 6, o = idx & 63; float s = C.in[I_FB1][l * 64 + o];
            for (int e = 0; e < 33; ++e) s += z[jj * 33 + e] * C.in[I_FW1][((size_t)l * 33 + e) * 64 + o];
            h1[idx] = sinf(C.in[I_FF1][l * 64 + o] * s); }
        __syncthreads();
        for (int idx = C.tid; idx < 1024; idx += 512) { const int jj = idx >> 6, o = idx & 63; float s = C.in[I_FB2][l * 64 + o];
            for (int e = 0; e < 64; ++e) s += h1[jj * 64 + e] * C.in[I_FW2][((size_t)l * 64 + e) * 64 + o];
            h2[idx] = sinf(C.in[I_FF2][l * 64 + o] * s); }
        __syncthreads();
        const int col = C.tid * 4, o = col >> 10, dir = (col >> 9) & 1, c0 = col & 511;
        f32x4 acc[16];
#pragma unroll
        for (int jj = 0; jj < 16; ++jj) acc[jj] = (f32x4){0.f, 0.f, 0.f, 0.f};
        for (int i = 0; i < 64; ++i) { const f32x4 w = *(const f32x4*)(C.in[I_FW3] + ((size_t)l * 64 + i) * 2048 + col);
#pragma unroll
            for (int jj = 0; jj < 16; ++jj) acc[jj] += w * h2[jj * 64 + i]; }
        bf16* fb = (bf16*)(C.ws + WS_FILT + (size_t)l * FILT_LAYER + (grp ? FILT_CTX_OFF : 0));
#pragma unroll
        for (int jj = 0; jj < 16; ++jj) { const int j = j0 + jj; const float t = (float)j / (float)(L - 1);
#pragma unroll
            for (int e = 0; e < 4; ++e) { const int c = c0 + e; const float delta = fabsf(HY_MIN + (float)c * ((HY_MAX - HY_MIN) / 511.0f));
                float val = acc[jj][e] * expf(-t * delta); int eidx = dir ? (L + j) : (L - j);
                if (dir && j == 0) { eidx = 0; val = 0.f; }
                fb[((size_t)(o * 512 + c)) * (2 * L) + eidx] = (bf16)f2bf(val); } }
    }
}

__device__ __forceinline__ void p0_rope(const Ctx& C) {
    float* rc = (float*)(C.ws + WS_ROPE);
    for (int idx = C.bid * 512 + C.tid; idx < 2048 * 32; idx += C.G * 512) { const int t = idx >> 5, i = idx & 31; const float inv = exp2f(-(float)(i & 15) * (13.287712379549449f / 16.0f));
        const float ang = (float)((i < 16) ? (t >> 6) : (t & 63)) * inv; rc[idx] = cosf(ang); rc[65536 + idx] = sinf(ang); }
}

__device__ __forceinline__ void p0_h0(const Ctx& C) {
    const float* mod = (const float*)(C.ws + WS_MOD);
    bf16* H = (bf16*)(C.ws + WS_H);
    const int total = M * (D / 8);
    for (int task = C.bid * 512 + C.tid; task < total; task += C.G * 512) {
        const int row = task >> 8, c8 = (task & 255) * 8;
        const float* xp = (row < MC) ? C.in[I_XP] + (size_t)row * D + c8 : C.in[I_XS] + (size_t)(row - MC) * D + c8;
        const int bi = (row < MC) ? 8 : ((row - MC) >> 11);
        const float* mp = mod + (size_t)bi * NMOD + c8;
        const f32x4 x0 = *(const f32x4*)xp, x1 = *(const f32x4*)(xp + 4), sh0 = *(const f32x4*)mp, sh1 = *(const f32x4*)(mp + 4), s0 = *(const f32x4*)(mp + D), s1 = *(const f32x4*)(mp + D + 4);
        const f32x4 h0 = x0 * (s0 + 1.0f) + sh0, h1 = x1 * (s1 + 1.0f) + sh1;
        u32x4 w; w.x = pk2(h0[0], h0[1]); w.y = pk2(h0[2], h0[3]); w.z = pk2(h1[0], h1[1]); w.w = pk2(h1[2], h1[3]);
        *(u32x4*)(H + (size_t)row * D + c8) = w;
    }
}

__device__ __forceinline__ void ln_phase(const Ctx& C, float* buf, const float* g, const float* b, const float* modl  , int shift_off, int scale_off, bf16* H) {
    const int lane = C.lane;
    f32x4 gv[8], bv[8];
#pragma unroll
    for (int i = 0; i < 8; ++i) { gv[i] = *(const f32x4*)(g + lane * 4 + 256 * i); bv[i] = *(const f32x4*)(b + lane * 4 + 256 * i); }
    for (int row = C.bid * 8 + C.wave; row < M; row += C.G * 8) {
        float* rp = buf + (size_t)row * D + lane * 4;
        f32x4 v[8]; float s = 0.f;
#pragma unroll
        for (int i = 0; i < 8; ++i) { v[i] = *(const f32x4*)(rp + 256 * i); s += (v[i][0] + v[i][1]) + (v[i][2] + v[i][3]); }
        const float mu = wave_sum(s) * (1.0f / 2048.0f);
        float q = 0.f;
#pragma unroll
        for (int i = 0; i < 8; ++i) { v[i] = v[i] - mu; q += (v[i][0] * v[i][0] + v[i][1] * v[i][1]) + (v[i][2] * v[i][2] + v[i][3] * v[i][3]); }
        const float rstd = rsqrtf(wave_sum(q) * (1.0f / 2048.0f) + LN_EPS);
        const int bi = (row < MC) ? 8 : ((row - MC) >> 11);
#pragma unroll
        for (int i = 0; i < 8; ++i) { const f32x4 y = v[i] * rstd * gv[i] + bv[i]; *(f32x4*)(rp + 256 * i) = y;
            if (modl) { const float* mp = modl + (size_t)bi * NMOD + lane * 4 + 256 * i; const f32x4 sh = *(const f32x4*)(mp + shift_off), sc = *(const f32x4*)(mp + scale_off);
                const f32x4 h = y * (sc + 1.0f) + sh; u32x2 w; w.x = pk2(h[0], h[1]); w.y = pk2(h[2], h[3]); *(u32x2*)(H + (size_t)row * D + lane * 4 + 256 * i) = w; } }
    }
}

__device__ __forceinline__ void gate_fixup_phase(const Ctx& C, const float* halo, const float* cw, bf16* Gb) {
    for (int idx = C.bid * 512 + C.tid; idx < 56 * DFF; idx += C.G * 512) {
        const int seam = idx / DFF, j = idx % DFF, p = 32 + (seam / 7) * 8 + (seam % 7);
        const float* h0 = halo + (size_t)p * 4 * 11008; const float* h1 = halo + (size_t)(p + 1) * 4 * 11008;
        const float a254 = h0[2 * 11008 + j], a255 = h0[3 * 11008 + j], a0 = h1[j], a1 = h1[11008 + j];
        const float b254 = h0[2 * 11008 + 5504 + j], b255 = h0[3 * 11008 + 5504 + j], b0 = h1[5504 + j], b1 = h1[11008 + 5504 + j];
        const float wa0 = cw[j], wa1 = cw[11008 + j], wa2 = cw[2 * 11008 + j], wb0 = cw[5504 + j], wb1 = cw[11008 + 5504 + j], wb2 = cw[2 * 11008 + 5504 + j];
        const float ca = wa0 * a254 + wa1 * a255 + wa2 * a0, cb = wb0 * b254 + wb1 * b255 + wb2 * b0;
        const float da = wa0 * a255 + wa1 * a0 + wa2 * a1, db = wb0 * b255 + wb1 * b0 + wb2 * b1;
        Gb[(size_t)(p * 256 + 255) * DFF + j] = (bf16)f2bf(ca * __builtin_amdgcn_rcpf(1.0f + __expf(-ca)) * cb);
        Gb[(size_t)((p + 1) * 256) * DFF + j] = (bf16)f2bf(da * __builtin_amdgcn_rcpf(1.0f + __expf(-da)) * db);
    }
}

constexpr int AT_KS = 72;
constexpr int AT_VS = 72;
constexpr int AT_KOFF = 0, AT_VOFF = 64 * AT_KS * 2;

constexpr int AT_BUF = 2 * 64 * AT_KS * 2;
struct AttnRegs { u32x4 a, b, c, d; };
__device__ __forceinline__ void attn_load(const Ctx& C, AttnRegs& R, bool f32src, const void* kptr, const void* vptr, int ld, bool rope, int tpos0, const float* ropec) {
    const int key = C.tid & 63, part = C.tid >> 6;
    if (f32src) {
        const float* kp = (const float*)kptr + (size_t)key * ld + part * 8; const float* vp = (const float*)vptr + (size_t)key * ld + part * 8;
        R.a = *(const u32x4*)kp; R.b = *(const u32x4*)(kp + 4); R.c = *(const u32x4*)vp; R.d = *(const u32x4*)(vp + 4);
    } else {
        const bf16* kp = (const bf16*)kptr + (size_t)key * ld + part * 8; const bf16* vp = (const bf16*)vptr + (size_t)key * ld + part * 8;
        R.a = *(const u32x4*)kp; R.b = *(const u32x4*)vp;
        if (rope) R.c = *(const u32x4*)((const bf16*)kptr + (size_t)key * ld + (part ^ 4) * 8);
    }
}
__device__ __forceinline__ void attn_write(const Ctx& C, const AttnRegs& R, bool f32src, bool rope, LAS unsigned char* buf, int tpos0, const float* ropec) {
    LAS bf16* Kc = (LAS bf16*)(buf + AT_KOFF); LAS bf16* Vt = (LAS bf16*)(buf + AT_VOFF);
    const int key = C.tid & 63, part = C.tid >> 6;
    float kf[8], vf[8];
    if (f32src) {
#pragma unroll
        for (int e = 0; e < 4; ++e) { kf[e] = __uint_as_float(R.a[e]); kf[4 + e] = __uint_as_float(R.b[e]); vf[e] = __uint_as_float(R.c[e]); vf[4 + e] = __uint_as_float(R.d[e]); }
    } else {
#pragma unroll
        for (int e = 0; e < 4; ++e) { kf[2 * e] = bflo(R.a[e]); kf[2 * e + 1] = bfhi(R.a[e]); vf[2 * e] = bflo(R.b[e]); vf[2 * e + 1] = bfhi(R.b[e]); }
        if (rope) {
            const float* cp = ropec + (size_t)(tpos0 + key) * 32 + (part & 3) * 8; const f32x4 cs0 = *(const f32x4*)cp, cs1 = *(const f32x4*)(cp + 4), sn0 = *(const f32x4*)(cp + 65536), sn1 = *(const f32x4*)(cp + 65536 + 4);
#pragma unroll
            for (int e = 0; e < 8; ++e) { const float other = (e & 1) ? bfhi(R.c[e >> 1]) : bflo(R.c[e >> 1]); const float cs = (e < 4) ? cs0[e & 3] : cs1[e & 3], sn = (e < 4) ? sn0[e & 3] : sn1[e & 3];
                kf[e] = (part < 4) ? (kf[e] * cs - other * sn) : (other * sn + kf[e] * cs); }
        }
    }
    u32x4 w; w.x = pk2(kf[0], kf[1]); w.y = pk2(kf[2], kf[3]); w.z = pk2(kf[4], kf[5]); w.w = pk2(kf[6], kf[7]);
    *(LAS u32x4*)(Kc + key * AT_KS + part * 8) = w;
    const unsigned v01 = pk2(vf[0], vf[1]), v23 = pk2(vf[2], vf[3]), v45 = pk2(vf[4], vf[5]), v67 = pk2(vf[6], vf[7]);
    Vt[(part * 8 + 0) * AT_VS + key] = (bf16)v01; Vt[(part * 8 + 1) * AT_VS + key] = (bf16)(v01 >> 16); Vt[(part * 8 + 2) * AT_VS + key] = (bf16)v23; Vt[(part * 8 + 3) * AT_VS + key] = (bf16)(v23 >> 16);
    Vt[(part * 8 + 4) * AT_VS + key] = (bf16)v45; Vt[(part * 8 + 5) * AT_VS + key] = (bf16)(v45 >> 16); Vt[(part * 8 + 6) * AT_VS + key] = (bf16)v67; Vt[(part * 8 + 7) * AT_VS + key] = (bf16)(v67 >> 16);
}

__device__ __forceinline__ void attn_item3(const Ctx& C, int layer, bool latent, int b, int hk, int qblk) {
    const bf16* qkv = (const bf16*)(C.ws + WS_QKV);
    bf16* mix = (bf16*)(C.ws + WS_MIX);
    const float* ropec = (const float*)(C.ws + WS_ROPE);
    const int T = latent ? T_D : T_C, row_base = latent ? MC + b * T_D : b * T_C, q0 = qblk * 256;
    const int lane = C.lane, n = lane & 31, hh = lane >> 5, qw = q0 + C.wave * 32, qpos = qw + n;
    const float LOG2E = 1.4426950408889634f;
    float sink2[3];
#pragma unroll
    for (int g = 0; g < 3; ++g) sink2[g] = C.in[I_SINK][layer * AH + hk * 3 + g] * LOG2E;
    LAS unsigned char* qs_lds = C.lds + 2 * AT_BUF + C.wave * (3 * 4 * 1024) + lane * 16;
#pragma unroll
    for (int g = 0; g < 3; ++g) { const bf16* qp = qkv + (size_t)(row_base + qpos) * NQKV + (hk * 3 + g) * 64 + 8 * hh; float q[4][8];
#pragma unroll
      for (int ks = 0; ks < 4; ++ks) { const u32x4 a = *(const u32x4*)(qp + 16 * ks);
#pragma unroll
          for (int e = 0; e < 4; ++e) { q[ks][2 * e] = bflo(a[e]); q[ks][2 * e + 1] = bfhi(a[e]); } }
      if (latent) {
#pragma unroll
          for (int ks = 0; ks < 2; ++ks) { const float* cp = ropec + (size_t)qpos * 32 + 16 * ks + 8 * hh; const float* sp = cp + 65536;
#pragma unroll
              for (int e = 0; e < 8; ++e) { const float x1 = q[ks][e], x2 = q[ks + 2][e], cs = cp[e], sn = sp[e]; q[ks][e] = x1 * cs - x2 * sn; q[ks + 2][e] = x1 * sn + x2 * cs; } } }
      const float qs = 0.125f * LOG2E;
#pragma unroll
      for (int ks = 0; ks < 4; ++ks) { u32x4 w; w.x = pk2(q[ks][0] * qs, q[ks][1] * qs); w.y = pk2(q[ks][2] * qs, q[ks][3] * qs); w.z = pk2(q[ks][4] * qs, q[ks][5] * qs); w.w = pk2(q[ks][6] * qs, q[ks][7] * qs);
          *(LAS u32x4*)(qs_lds + (g * 4 + ks) * 1024) = w; } }
    f32x16 oacc[3][2]; float mrun[3], lrun[3];
#pragma unroll
    for (int g = 0; g < 3; ++g) { mrun[g] = sink2[g]; lrun[g] = 0.f;
#pragma unroll
        for (int i = 0; i < 16; ++i) { oacc[g][0][i] = 0.f; oacc[g][1][i] = 0.f; } }
    int nloc, kc0;
    if (latent) { const int lo = (q0 - 128 > 0) ? q0 - 128 : 0, hi = (q0 + 384 < T) ? q0 + 384 : T; kc0 = lo >> 6; nloc = (hi - lo) >> 6; } else { kc0 = 0; nloc = 4; }
    const int nch = nloc + (latent ? 8 : 0);
    AttnRegs R;
    auto chunk_src = [&](int ch, bool& f32src, const void*& kp, const void*& vp, int& ld, int& key0) {
        const bool loc = ch < nloc; key0 = loc ? (kc0 + ch) * 64 : (ch - nloc) * 64; f32src = !loc;
        if (loc) { const bf16* p = qkv + (size_t)(row_base + key0) * NQKV + 768 + hk * 64; kp = p; vp = p + 256; ld = NQKV; }
        else { const size_t off = (((size_t)b * DEPTH + layer) * PAST + key0) * KVW + hk * 64; kp = C.in[I_CK] + off; vp = C.in[I_CV] + off; ld = KVW; } };
    { bool f; const void* kp; const void* vp; int ld, k0; chunk_src(0, f, kp, vp, ld, k0); attn_load(C, R, f, kp, vp, ld, latent && !f, k0, ropec); }
    __syncthreads();
    for (int ch = 0; ch < nch; ++ch) {
        const bool loc = ch < nloc;
        const int key0 = loc ? (kc0 + ch) * 64 : (ch - nloc) * 64;
        LAS unsigned char* buf = C.lds + (ch & 1) * AT_BUF;
        attn_write(C, R, !loc, latent && loc, buf, key0, ropec);
        __syncthreads();
        if (ch + 1 < nch) { bool f; const void* kp; const void* vp; int ld, k0; chunk_src(ch + 1, f, kp, vp, ld, k0); attn_load(C, R, f, kp, vp, ld, latent && !f, k0, ropec); }
        LAS bf16* Kc = (LAS bf16*)(buf + AT_KOFF); LAS bf16* Vt = (LAS bf16*)(buf + AT_VOFF);
#pragma unroll 1
        for (int tt = 0; tt < 2; ++tt) {
            const int k0t = key0 + 32 * tt;
            if (loc && latent && (k0t + 31 < qw - 128 || k0t > qw + 31 + 128)) continue;
#pragma unroll
            for (int g = 0; g < 3; ++g) {
            __builtin_amdgcn_sched_barrier(0);
            f32x16 s;
#pragma unroll
            for (int i = 0; i < 16; ++i) s[i] = -mrun[g];
#pragma unroll
            for (int ks = 0; ks < 4; ++ks) { const bf16x8 kf = *(const LAS bf16x8*)(Kc + (32 * tt + n) * AT_KS + 16 * ks + 8 * hh); s = __builtin_amdgcn_mfma_f32_32x32x16_bf16(kf, *(const LAS bf16x8*)(qs_lds + (g * 4 + ks) * 1024), s, 0, 0, 0); }
            if (loc && latent && (k0t < qw - 97 || k0t > qw + 97)) {
#pragma unroll
                for (int i = 0; i < 16; ++i) { const int kpos = k0t + (i & 3) + 8 * (i >> 2) + 4 * hh; const int dlt = qpos - kpos; if (dlt > 128 || dlt < -128) s[i] = -1e30f; } }
            float mx = fmaxf(fmaxf(s[0], s[1]), s[2]);
#pragma unroll
            for (int i = 3; i < 15; i += 2) mx = fmaxf(fmaxf(mx, s[i]), s[i + 1]);
            mx = fmaxf(mx, s[15]);
            mx = fmaxf(mx, __shfl_xor(mx, 32));
            if (__builtin_amdgcn_ballot_w64(mx > 8.0f) != 0ull) {
                const float up = fmaxf(mx, 0.f), alpha = exp2f(-up);
                mrun[g] += up; lrun[g] *= alpha;
#pragma unroll
                for (int i = 0; i < 16; ++i) { oacc[g][0][i] *= alpha; oacc[g][1][i] *= alpha; s[i] -= up; }
            }
            float ps = 0.f;
#pragma unroll
            for (int i = 0; i < 16; ++i) { s[i] = __builtin_amdgcn_exp2f(s[i]); ps += s[i]; }
            lrun[g] += ps;
#pragma unroll
            for (int s2 = 0; s2 < 2; ++s2) {
                u32x4 pw; pw.x = pk2(s[8 * s2 + 0], s[8 * s2 + 1]); pw.y = pk2(s[8 * s2 + 2], s[8 * s2 + 3]); pw.z = pk2(s[8 * s2 + 4], s[8 * s2 + 5]); pw.w = pk2(s[8 * s2 + 6], s[8 * s2 + 7]);
                const bf16x8 pf = __builtin_bit_cast(bf16x8, pw);
#pragma unroll
                for (int mt = 0; mt < 2; ++mt) {
                    const LAS bf16* vp = Vt + (32 * mt + n) * AT_VS + 32 * tt + 16 * s2 + 4 * hh;
                    const u32x2 v0 = *(const LAS u32x2*)vp, v1 = *(const LAS u32x2*)(vp + 8);
                    u32x4 vw; vw.x = v0.x; vw.y = v0.y; vw.z = v1.x; vw.w = v1.y;
                    oacc[g][mt] = __builtin_amdgcn_mfma_f32_32x32x16_bf16(__builtin_bit_cast(bf16x8, vw), pf, oacc[g][mt], 0, 0, 0);
                }
            }
            }
        }
    }
#pragma unroll
    for (int g = 0; g < 3; ++g) {
    const float ltot = lrun[g] + __shfl_xor(lrun[g], 32) + exp2f(sink2[g] - mrun[g]), inv = 1.0f / ltot;
    bf16* op = mix + (size_t)(row_base + qpos) * D + 1280 + (hk * 3 + g) * 64;
#pragma unroll
    for (int mt = 0; mt < 2; ++mt)
#pragma unroll
        for (int gg = 0; gg < 4; ++gg) { u32x2 w; w.x = pk2(oacc[g][mt][4 * gg] * inv, oacc[g][mt][4 * gg + 1] * inv); w.y = pk2(oacc[g][mt][4 * gg + 2] * inv, oacc[g][mt][4 * gg + 3] * inv);
            *(u32x2*)(op + 32 * mt + 8 * gg + 4 * hh) = w; }
    }
}

template <int GRP>
__device__ __forceinline__ void hyena_item(const Ctx& C, int layer, int c) {
    constexpr int L = GRP ? 256 : 2048, NBt = GRP ? 32 : 8, NTAU = L / 64, NCOL = NTAU * NBt, NN = GRP ? 1 : 2;
    constexpr int CS = GRP ? 1088 : 8256;
    constexpr int ZOFF = 8 * 8256, ZS = 144, XOFF = ZOFF + (256 + 16) * ZS;
    constexpr int row_base = GRP ? 0 : MC;
    const bf16* hyt = (const bf16*)(C.ws + WS_HYT);
    bf16* hyo = (bf16*)(C.ws + WS_HYO);
    const int tid = C.tid, lane = C.lane, wave = C.wave;
    LAS unsigned char* FC = C.lds; LAS unsigned char* ZB = C.lds + ZOFF; LAS unsigned char* XB = C.lds + XOFF;
    const int i16 = lane & 15, kg = lane >> 4;
    __syncthreads();
    auto load_stream = [&](int stream, LAS unsigned char* dst, int pad) {
        const bf16* src = hyt + (size_t)(stream * 512 + c) * M + row_base;
        const float w0 = C.in[I_HSW][((size_t)layer * 3 + 0) * 1536 + stream * 512 + c], w1 = C.in[I_HSW][((size_t)layer * 3 + 1) * 1536 + stream * 512 + c], w2 = C.in[I_HSW][((size_t)layer * 3 + 2) * 1536 + stream * 512 + c];
        for (int task = tid; task < NBt * L / 8; task += 512) {
            const int b = task / (L / 8), t8 = (task % (L / 8)) * 8;
            const bf16* p = src + b * L + t8;
            const u32x4 a = *(const u32x4*)p; float x[10];
            x[0] = (t8 > 0) ? bf2f(p[-1]) : 0.f; x[9] = (t8 + 8 < L) ? bf2f(p[8]) : 0.f;
#pragma unroll
            for (int e = 0; e < 4; ++e) { x[1 + 2 * e] = bflo(a[e]); x[2 + 2 * e] = bfhi(a[e]); }
            float y[8];
#pragma unroll
            for (int e = 0; e < 8; ++e) y[e] = w0 * x[e] + w1 * x[e + 1] + w2 * x[e + 2];
            u32x4 w; w.x = pk2(y[0], y[1]); w.y = pk2(y[2], y[3]); w.z = pk2(y[4], y[5]); w.w = pk2(y[6], y[7]);
            const int col = (t8 >> 6) * NBt + b, j = t8 & 63;
            *(LAS u32x4*)(dst + (col + pad) * ZS + j * 2) = w;
        }
    };
    auto load_filter = [&](int o) {
        const bf16* g = (const bf16*)(C.ws + WS_FILT + (size_t)layer * FILT_LAYER + (GRP ? FILT_CTX_OFF : 0)) + (size_t)(o * 512 + c) * (2 * L);
        for (int ch = tid; ch < (2 * L + 16) / 8; ch += 512) { u32x4 w = (u32x4){0u, 0u, 0u, 0u}; if (ch < 2 * L / 8) w = *(const u32x4*)(g + ch * 8); *(LAS u32x4*)(FC + ch * 16) = w; }
        __syncthreads();
        LAS bf16* c0 = (LAS bf16*)FC;
        for (int task = tid; task < 7 * ((2 * L + 16) / 8); task += 512) { const int r = 1 + task / ((2 * L + 16) / 8), y8 = (task % ((2 * L + 16) / 8)) * 8; unsigned e[8];
#pragma unroll
            for (int jj = 0; jj < 8; ++jj) { const int y = y8 - r + jj; e[jj] = (y >= 0) ? (unsigned)c0[y] : 0u; }
            u32x4 w; w.x = e[0] | (e[1] << 16); w.y = e[2] | (e[3] << 16); w.z = e[4] | (e[5] << 16); w.w = e[6] | (e[7] << 16);
            *(LAS u32x4*)(FC + r * CS + y8 * 2) = w; }
    };
    for (int i = tid; i < 16 * 32; i += 512) { const int pc = i >> 5, q = i & 31; const int col = (pc < 8) ? pc : NCOL + pc; *(LAS unsigned*)(ZB + col * ZS + q * 4) = 0u; }
    load_stream(0, ZB, 8);
    load_stream(1, XB, 0);
    f32x4 acc[4][NN];
#pragma unroll
    for (int o = 0; o < 2; ++o) {
        load_filter(o);
        __syncthreads();
#pragma unroll
        for (int mi = 0; mi < 4; ++mi)
#pragma unroll
            for (int nn = 0; nn < NN; ++nn) acc[mi][nn] = (f32x4){0.f, 0.f, 0.f, 0.f};
        for (int db = -(NTAU - 1); db <= NTAU - 1; ++db) {
            bool val[NN]; bool any = false;
#pragma unroll
            for (int nn = 0; nn < NN; ++nn) { const int sc0 = 16 * (wave * NN + nn) - NBt * db; val[nn] = (sc0 + 15 >= 0) && (sc0 < NCOL); any |= val[nn]; }
            if (!any) continue;
            bf16x8 af[4][2];
#pragma unroll
            for (int mi = 0; mi < 4; ++mi)
#pragma unroll
                for (int ks = 0; ks < 2; ++ks) { const int y = L - 64 * db - 16 * mi - 8 * (i16 >> 3) + 32 * ks + 8 * kg; af[mi][ks] = *(const LAS bf16x8*)(FC + (i16 & 7) * CS + y * 2); }
#pragma unroll
            for (int nn = 0; nn < NN; ++nn) {
                if (!val[nn]) continue;
                const int col = 16 * (wave * NN + nn) + i16 - NBt * db + 8;
#pragma unroll
                for (int ks = 0; ks < 2; ++ks) { const bf16x8 bfr = *(const LAS bf16x8*)(ZB + col * ZS + (32 * ks + 8 * kg) * 2);
#pragma unroll
                    for (int mi = 0; mi < 4; ++mi) acc[mi][nn] = __builtin_amdgcn_mfma_f32_16x16x32_bf16(af[mi][ks], bfr, acc[mi][nn], 0, 0, 0); }
            }
        }
        __syncthreads();
        const float bias = C.in[I_HBIAS][((size_t)layer * 2 + o) * 512 + c];
#pragma unroll
        for (int nn = 0; nn < NN; ++nn) {
            const int col = 16 * (wave * NN + nn) + i16;
#pragma unroll
            for (int mi = 0; mi < 4; ++mi) { const int i0 = 16 * mi + 4 * kg;
                LAS u32x2* zp = (LAS u32x2*)(ZB + (col + 8) * ZS + i0 * 2); const u32x2 zv = *zp, xv = *(const LAS u32x2*)(XB + col * ZS + i0 * 2);
                const float z0 = bflo(zv.x), z1 = bfhi(zv.x), z2 = bflo(zv.y), z3 = bfhi(zv.y);
                const float r0 = bflo(xv.x) * (acc[mi][nn][0] + bias * z0), r1 = bfhi(xv.x) * (acc[mi][nn][1] + bias * z1), r2 = bflo(xv.y) * (acc[mi][nn][2] + bias * z2), r3 = bfhi(xv.y) * (acc[mi][nn][3] + bias * z3);
                u32x2 w; w.x = pk2(r0, r1); w.y = pk2(r2, r3);
                if (o == 0) *zp = w;
                else { const int tau = col / NBt, b = col % NBt; *(u32x2*)(hyo + (size_t)c * M + row_base + b * L + 64 * tau + i0) = w; } }
        }
        if (o == 0) { __syncthreads(); load_stream(2, XB, 0); }
    }
}

__device__ __forceinline__ void fin_phase(const Ctx& C, int layer) {
    const float* of = (const float*)(C.ws + WS_OF); const float* ob = (const float*)(C.ws + WS_OB); const float* bs = (const float*)(C.ws + WS_BS);
    const bf16* rkvg = (const bf16*)(C.ws + WS_RKVG); bf16* mix = (bf16*)(C.ws + WS_MIX);
    const int lane = C.lane;
    { const int hq = lane >> 4, c4 = (lane & 15) * 4;
    for (int task = C.bid * 8 + C.wave; task < M * 3; task += C.G * 8) {
        const int token = task / 3, h = (task % 3) * 4 + hq; const size_t oi = (size_t)token * RW + h * 64 + c4;
#if DBG_SKIP_RWKV
        *(u32x2*)(mix + (size_t)token * D + h * 64 + c4) = (u32x2){0u, 0u};
#else
        const f32x4 o = *(const f32x4*)(of + oi) + *(const f32x4*)(ob + oi);
        const float mu = row16_sum((o[0] + o[1]) + (o[2] + o[3])) * (1.0f / 64.0f);
        const f32x4 dd = o - mu;
        const float var = row16_sum((dd[0] * dd[0] + dd[1] * dd[1]) + (dd[2] * dd[2] + dd[3] * dd[3])) * (1.0f / 64.0f);
        const f32x4 lg = *(const f32x4*)(C.in[I_LNXG] + layer * RW + h * 64 + c4), lb = *(const f32x4*)(C.in[I_LNXB] + layer * RW + h * 64 + c4);
        const f32x4 on = dd * (lg * rsqrtf(var + GN_EPS)) + lb;
        const float bon = bs[(size_t)h * M + token] + bs[(size_t)(RH + h) * M + token];
        const u32x2 vw = *(const u32x2*)(rkvg + (size_t)token * 3072 + 1536 + h * 64 + c4), gw = *(const u32x2*)(rkvg + (size_t)token * 3072 + 2304 + h * 64 + c4);
        const float r0 = (on[0] + bon * bflo(vw.x)) * __builtin_amdgcn_rcpf(1.0f + __expf(-bflo(gw.x))), r1 = (on[1] + bon * bfhi(vw.x)) * __builtin_amdgcn_rcpf(1.0f + __expf(-bfhi(gw.x)));
        const float r2 = (on[2] + bon * bflo(vw.y)) * __builtin_amdgcn_rcpf(1.0f + __expf(-bflo(gw.y))), r3 = (on[3] + bon * bfhi(vw.y)) * __builtin_amdgcn_rcpf(1.0f + __expf(-bfhi(gw.y)));
        u32x2 w; w.x = pk2(r0, r1); w.y = pk2(r2, r3);
        *(u32x2*)(mix + (size_t)token * D + h * 64 + c4) = w;
#endif
    } }
    const bf16* hyo = (const bf16*)(C.ws + WS_HYO);
    LAS bf16* tile = (LAS bf16*)C.lds;
    for (int job = C.bid; job < 8 * (M / 64); job += C.G) {
        const int ct = job / (M / 64), tt = job % (M / 64), c0 = ct * 64, tok0 = tt * 64;
        __syncthreads();
        { const int c = C.tid >> 3, t8 = (C.tid & 7) * 8;
#if DBG_SKIP_HYENA
          const u32x4 w = (u32x4){0u, 0u, 0u, 0u};
#else
          const u32x4 w = *(const u32x4*)(hyo + (size_t)(c0 + c) * M + tok0 + t8);
#endif
          *(LAS u32x4*)(tile + c * 72 + t8) = w; }
        __syncthreads();
        { const int tok = C.tid >> 3, c8 = (C.tid & 7) * 8; unsigned e[8];
#pragma unroll
          for (int j = 0; j < 8; ++j) e[j] = tile[(c8 + j) * 72 + tok];
          u32x4 w; w.x = e[0] | (e[1] << 16); w.y = e[2] | (e[3] << 16); w.z = e[4] | (e[5] << 16); w.w = e[6] | (e[7] << 16);
          *(u32x4*)(mix + (size_t)(tok0 + tok) * D + 768 + c0 + c8) = w; }
    }
}

constexpr int S2_PT = 0, S2_RT = 2048, S2_QT = 4096, S2_KT = 6144, S2_QK = 8192, S2_VM = 12288, S2_A2T = 14336, S2_A34 = 14848, S2_TT = 15872, S2_GC = 16384, S2_A1F = 16640, S2_BON = 17664, S2_SLOT = 19712;
__device__ __forceinline__ float fast_sigmoid(float x) { return __builtin_amdgcn_rcpf(1.0f + __expf(-x)); }
__device__ __forceinline__ float wave64_sum(float x) { x = row16_sum(x); const int xi = __float_as_int(x);
    const float a = __int_as_float(__builtin_amdgcn_readlane(xi, 0)), b = __int_as_float(__builtin_amdgcn_readlane(xi, 16)), c = __int_as_float(__builtin_amdgcn_readlane(xi, 32)), d = __int_as_float(__builtin_amdgcn_readlane(xi, 48));
    return (a + b) + (c + d); }
__device__ __forceinline__ s16x4 pack4(const f32x4& v) { u32x2 w; w.x = pk2(v[0], v[1]); w.y = pk2(v[2], v[3]); return __builtin_bit_cast(s16x4, w); }
__device__ __forceinline__ bf16x8 pack8(const f32x4& a, const f32x4& b) { u32x4 w; w.x = pk2(a[0], a[1]); w.y = pk2(a[2], a[3]); w.z = pk2(b[0], b[1]); w.w = pk2(b[2], b[3]); return __builtin_bit_cast(bf16x8, w); }
__device__ __forceinline__ bf16x8 cat8(const s16x4& a, const s16x4& b) { bf16x8 r; r[0] = a[0]; r[1] = a[1]; r[2] = a[2]; r[3] = a[3]; r[4] = b[0]; r[5] = b[1]; r[6] = b[2]; r[7] = b[3]; return r; }

__device__ __forceinline__ void kknorm_phase(const Ctx& C, int layer) {
    const bf16* rkvg = (const bf16*)(C.ws + WS_RKVG); float* inv = (float*)(C.ws + WS_INV);
    for (int task = C.bid * 512 + C.tid; task < M * RH; task += C.G * 512) {
        const int token = task / RH, h = task % RH;
        const bf16* kp = rkvg + (size_t)token * 3072 + 768 + h * 64; const float* pk = C.in[I_KK] + layer * RW + h * 64;
        float ss = 0.f;
#pragma unroll
        for (int q = 0; q < 8; ++q) { const u32x4 a = *(const u32x4*)(kp + 8 * q); const f32x4 p0 = *(const f32x4*)(pk + 8 * q), p1 = *(const f32x4*)(pk + 8 * q + 4);
            const float x0 = bflo(a[0]) * p0[0], x1 = bfhi(a[0]) * p0[1], x2 = bflo(a[1]) * p0[2], x3 = bfhi(a[1]) * p0[3], x4 = bflo(a[2]) * p1[0], x5 = bfhi(a[2]) * p1[1], x6 = bflo(a[3]) * p1[2], x7 = bfhi(a[3]) * p1[3];
            ss += (x0 * x0 + x1 * x1) + (x2 * x2 + x3 * x3) + (x4 * x4 + x5 * x5) + (x6 * x6 + x7 * x7); }
        inv[task] = __builtin_amdgcn_rsqf(fmaxf(ss, 1e-24f));
    }
}

__device__ __forceinline__ void scan2_item(const Ctx& C, int layer, int item) {
    const int latent = item < 192; const int it2 = latent ? item : item - 192;
    const int b = it2 / 24, h = (it2 % 24) >> 1, d = it2 & 1;
    const int T = latent ? T_D : T_C, row_base = latent ? MC + b * T_D : b * T_C, nch = T / 16;
    const bf16* rkvg = (const bf16*)(C.ws + WS_RKVG); const bf16* lw = (const bf16*)(C.ws + WS_LW);
    float* obase = (float*)(C.ws + (d ? WS_OB : WS_OF)); float* bs = (float*)(C.ws + WS_BS); const float* invn = (const float*)(C.ws + WS_INV);
    const int lane = C.lane, wave = C.wave, c16 = lane & 15, quad = lane >> 4;
    __syncthreads();
    if (wave == 0) {
        f32x4 S[4][4];
        const size_t soff = ((((size_t)b * DEPTH + layer) * 2 + d) * RH + h) * 4096;
#pragma unroll
        for (int kt = 0; kt < 4; ++kt)
#pragma unroll
            for (int vt = 0; vt < 4; ++vt) S[kt][vt] = latent ? *(const f32x4*)(C.in[I_STATE] + soff + (16 * vt + c16) * 64 + 16 * kt + 4 * quad) : (f32x4){0.f, 0.f, 0.f, 0.f};
        for (int it = -6; it < nch; ++it) {
            if (it >= 0) {
                const LAS unsigned char* sl = C.lds + (it % 7) * S2_SLOT;
                bf16x8 sf[2][4];
#pragma unroll
                for (int ks = 0; ks < 2; ++ks)
#pragma unroll
                    for (int vt = 0; vt < 4; ++vt) sf[ks][vt] = pack8(S[2 * ks][vt], S[2 * ks + 1][vt]);
                const bf16x8 pt0 = *(const LAS bf16x8*)(sl + S2_PT + lane * 16), pt1 = *(const LAS bf16x8*)(sl + S2_PT + (64 + lane) * 16);
                const bf16x8 rt0 = *(const LAS bf16x8*)(sl + S2_RT + lane * 16), rt1 = *(const LAS bf16x8*)(sl + S2_RT + (64 + lane) * 16);
                const s16x4 a2t = *(const LAS s16x4*)(sl + S2_A2T + lane * 8), tt = *(const LAS s16x4*)(sl + S2_TT + lane * 8);
                const bf16x8 a34 = *(const LAS bf16x8*)(sl + S2_A34 + lane * 16);
                f32x4 O[4]; bf16x8 uv[4]; const s16x4 z4 = (s16x4){0, 0, 0, 0};
#pragma unroll
                for (int vt = 0; vt < 4; ++vt) {
                    const s16x4 vm = *(const LAS s16x4*)(sl + S2_VM + (vt * 64 + lane) * 8);
                    f32x4 w = (f32x4){0.f, 0.f, 0.f, 0.f}, o = w;
                    w = __builtin_amdgcn_mfma_f32_16x16x32_bf16(pt0, sf[0][vt], w, 0, 0, 0);
                    w = __builtin_amdgcn_mfma_f32_16x16x32_bf16(pt1, sf[1][vt], w, 0, 0, 0);
                    w = __builtin_amdgcn_mfma_f32_16x16x32_bf16(cat8(a2t, z4), cat8(vm, z4), w, 0, 0, 0);
                    o = __builtin_amdgcn_mfma_f32_16x16x32_bf16(rt0, sf[0][vt], o, 0, 0, 0);
                    o = __builtin_amdgcn_mfma_f32_16x16x32_bf16(rt1, sf[1][vt], o, 0, 0, 0);
                    f32x4 u = (f32x4){0.f, 0.f, 0.f, 0.f};
                    u = __builtin_amdgcn_mfma_f32_16x16x32_bf16(cat8(tt, z4), cat8(pack4(w), z4), u, 0, 0, 0);
                    uv[vt] = cat8(pack4(u), vm);
                    O[vt] = __builtin_amdgcn_mfma_f32_16x16x32_bf16(a34, uv[vt], o, 0, 0, 0);
                }
#pragma unroll
                for (int kt = 0; kt < 4; ++kt) {
                    const bf16x8 qk = *(const LAS bf16x8*)(sl + S2_QK + (kt * 64 + lane) * 16);
                    const f32x4 g4 = *(const LAS f32x4*)(sl + S2_GC + (16 * kt + 4 * quad) * 4);
#pragma unroll
                    for (int vt = 0; vt < 4; ++vt) S[kt][vt] = __builtin_amdgcn_mfma_f32_16x16x32_bf16(qk, uv[vt], S[kt][vt], 0, 0, 0) * g4;
                }
#pragma unroll
                for (int rg = 0; rg < 4; ++rg) { const int step = it * 16 + 4 * quad + rg, t = d ? (T - 1 - step) : step; float* op = obase + (size_t)(row_base + t) * RW + h * 64 + c16;
#pragma unroll
                    for (int vt = 0; vt < 4; ++vt) op[16 * vt] = O[vt][rg]; }
            }
            __syncthreads();
        }
        if (!latent) {
#pragma unroll
            for (int kt = 0; kt < 4; ++kt)
#pragma unroll
                for (int vt = 0; vt < 4; ++vt) *(f32x4*)(C.out + O_STATE + soff + (16 * vt + c16) * 64 + 16 * kt + 4 * quad) = S[kt][vt];
        }
    } else {
        const int j = wave - 1, k = lane, pc = h * 64 + k;
        LAS unsigned char* sl = C.lds + j * S2_SLOT;
        const float pw0 = C.in[I_W0][(layer * 2 + d) * RW + pc], pa0 = C.in[I_A0][(layer * 2 + d) * RW + pc];
        const float pkk = C.in[I_KK][layer * RW + pc], pka = C.in[I_KA][layer * RW + pc], prk = C.in[I_RK][layer * RW + pc];
        const int ks_ = k >> 5, kk5 = k & 31, tl_lane = ((kk5 >> 2) & 3) * 16, tl_j = ((kk5 >> 4) << 2) | (kk5 & 3);
        const int qk_base = ((k >> 4) * 64 + (k & 15)) * 8;
        const int vm_base = ((k >> 4) * 64 + (k & 15)) * 4;
        float L = 0.f, Gprev = 1.f;
        unsigned short xr[4], xk[4], xv[4], xw[4], xa[4]; float xi[4];
#pragma unroll
        for (int ii = 0; ii < 4; ++ii) { xr[ii] = 0; xk[ii] = 0; xv[ii] = 0; xw[ii] = 0; xa[ii] = 0; xi[ii] = 0.f; }
        auto issue = [&](int itn) {
            int phn = (itn + 6 - j) % 7; if (phn < 0) phn += 7;
            const int cn = itn + 6 - phn;
            if (phn < 4 && cn >= 0 && cn < nch) {
#pragma unroll
                for (int ii = 0; ii < 4; ++ii) { const int step = cn * 16 + phn * 4 + ii, t = d ? (T - 1 - step) : step; const size_t row = (size_t)(row_base + t);
                    const bf16* rp = rkvg + row * 3072 + pc; xr[ii] = rp[0]; xk[ii] = rp[768]; xv[ii] = rp[1536];
                    const bf16* lp = lw + row * 3072 + d * 768 + pc; xw[ii] = lp[0]; xa[ii] = lp[1536]; xi[ii] = invn[row * RH + h]; }
            }
        };
        issue(-6);
        for (int it = -6; it < nch; ++it) {
            int ph = (it + 6 - j) % 7; if (ph < 0) ph += 7;
            const int c = it + 6 - ph;
            if (ph < 6 && c >= 0 && c < nch) {
                if (ph < 4) {
                    if (ph == 0) { L = 0.f; Gprev = 1.f; }
                    unsigned short yr[4], yk[4], yv[4], yw[4], ya[4]; float yi[4];
#pragma unroll
                    for (int ii = 0; ii < 4; ++ii) { yr[ii] = xr[ii]; yk[ii] = xk[ii]; yv[ii] = xv[ii]; yw[ii] = xw[ii]; ya[ii] = xa[ii]; yi[ii] = xi[ii]; }
                    issue(it + 1);
#pragma unroll
                    for (int ii = 0; ii < 4; ++ii) {
                        const int i = ph * 4 + ii, step = c * 16 + i, t = d ? (T - 1 - step) : step;
                        const float r = bf2f(yr[ii]), kx = bf2f(yk[ii]);
                        const float kk = kx * pkk * yi[ii];
                        const float e = 0.6065306597126334f * fast_sigmoid(pw0 + bf2f(yw[ii]));
                        L -= e;
                        const float Gp = Gprev, G = __expf(L), Gi = __builtin_amdgcn_rcpf(G); Gprev = G;
                        const float a = fast_sigmoid(pa0 + bf2f(ya[ii]));
                        const float q = kk * a, kd = kx * (1.0f + (a - 1.0f) * pka);
                        ((LAS bf16*)(sl + S2_BON))[i * 64 + k] = (bf16)f2bf(r * kd * prk);
                        const int ti = (ks_ * 64 + tl_lane + i) * 8 + tl_j;
                        const unsigned pr = pk2(-kk * Gp, r * G), qkp = pk2(q * Gi, kd * Gi);
                        ((LAS bf16*)(sl + S2_PT))[ti] = (bf16)pr;
                        ((LAS bf16*)(sl + S2_RT))[ti] = (bf16)(pr >> 16);
                        const unsigned qb = qkp & 0xffffu, kb = qkp >> 16;
                        ((LAS bf16*)(sl + S2_QT))[ti] = (bf16)qb;
                        ((LAS bf16*)(sl + S2_KT))[ti] = (bf16)kb;
                        const int qi = qk_base + (i >> 2) * 128 + (i & 3);
                        ((LAS bf16*)(sl + S2_QK))[qi] = (bf16)qb; ((LAS bf16*)(sl + S2_QK))[qi + 4] = (bf16)kb;
                        ((LAS bf16*)(sl + S2_VM))[vm_base + (i >> 2) * 64 + (i & 3)] = yv[ii];
                        if (i == 15) ((LAS float*)(sl + S2_GC))[k] = G;
                    }
                } else if (ph == 4) {
                    issue(it + 1);
                    { const int sb = lane >> 2, g = lane & 3; const u32x4 b0 = *(const LAS u32x4*)(sl + S2_BON + (sb * 64 + g * 16) * 2), b1 = *(const LAS u32x4*)(sl + S2_BON + (sb * 64 + g * 16 + 8) * 2);
                      float bsum = ((bflo(b0[0]) + bfhi(b0[0])) + (bflo(b0[1]) + bfhi(b0[1]))) + ((bflo(b0[2]) + bfhi(b0[2])) + (bflo(b0[3]) + bfhi(b0[3])));
                      bsum += ((bflo(b1[0]) + bfhi(b1[0])) + (bflo(b1[1]) + bfhi(b1[1]))) + ((bflo(b1[2]) + bfhi(b1[2])) + (bflo(b1[3]) + bfhi(b1[3])));
                      bsum += dpp_f<0xB1>(bsum); bsum += dpp_f<0x4E>(bsum);
                      if (g == 0) { const int step = c * 16 + sb, t = d ? (T - 1 - step) : step; bs[(size_t)(d * RH + h) * M + (row_base + t)] = bsum; } }
                    f32x4 a1 = (f32x4){0.f, 0.f, 0.f, 0.f}, a2 = a1, a3 = a1, a4 = a1;
#pragma unroll
                    for (int ks = 0; ks < 2; ++ks) {
                        const bf16x8 fq = *(const LAS bf16x8*)(sl + S2_QT + (ks * 64 + lane) * 16), fk = *(const LAS bf16x8*)(sl + S2_KT + (ks * 64 + lane) * 16);
                        const bf16x8 fp = *(const LAS bf16x8*)(sl + S2_PT + (ks * 64 + lane) * 16), fr = *(const LAS bf16x8*)(sl + S2_RT + (ks * 64 + lane) * 16);
                        a1 = __builtin_amdgcn_mfma_f32_16x16x32_bf16(fq, fp, a1, 0, 0, 0); a2 = __builtin_amdgcn_mfma_f32_16x16x32_bf16(fk, fp, a2, 0, 0, 0);
                        a3 = __builtin_amdgcn_mfma_f32_16x16x32_bf16(fq, fr, a3, 0, 0, 0); a4 = __builtin_amdgcn_mfma_f32_16x16x32_bf16(fk, fr, a4, 0, 0, 0);
                    }
#pragma unroll
                    for (int rg = 0; rg < 4; ++rg) { const int s = 4 * quad + rg; const bool lt = s < c16, le = s <= c16;
                        a1[rg] = lt ? a1[rg] : 0.f; a2[rg] = lt ? a2[rg] : 0.f; a3[rg] = le ? a3[rg] : 0.f; a4[rg] = le ? a4[rg] : 0.f;
                    }
                    *(LAS f32x4*)(sl + S2_A1F + (c16 * 16 + 4 * quad) * 4) = a1;
                    *(LAS s16x4*)(sl + S2_A2T + lane * 8) = pack4(a2);
                    *(LAS bf16x8*)(sl + S2_A34 + lane * 16) = pack8(a3, a4);
                } else {
                    issue(it + 1);
                    float tr[16];
#pragma unroll
                    for (int tb = 0; tb < 4; ++tb) {
                        f32x4 col[4][4];
#pragma unroll
                        for (int t4 = 0; t4 < 4; ++t4)
#pragma unroll
                            for (int q = 0; q <= tb; ++q) col[t4][q] = *(const LAS f32x4*)(sl + S2_A1F + ((4 * tb + t4) * 16 + 4 * q) * 4);
#pragma unroll
                        for (int t4 = 0; t4 < 4; ++t4) { const int t = 4 * tb + t4; float acc = (lane == t) ? 1.0f : 0.f;
#pragma unroll
                            for (int jj = 0; jj < t; ++jj) acc += tr[jj] * col[t4][jj >> 2][jj & 3];
                            tr[t] = acc; }
                    }
                    if (lane < 16) {
#pragma unroll
                        for (int t = 0; t < 16; ++t) ((LAS bf16*)(sl + S2_TT))[((lane >> 2) * 16 + t) * 4 + (lane & 3)] = (bf16)f2bf(tr[t]); }
                }
            } else issue(it + 1);
            __syncthreads();
        }
    }
}


__global__ void __launch_bounds__(512, 2) mega_fwd(Params P) {
    extern __shared__ __attribute__((aligned(16))) unsigned char lds_raw[];
#define MKCTX() Ctx C; { int tid_ = threadIdx.x; asm volatile("" : "+v"(tid_)); int z_ = 0; asm volatile("" : "+s"(z_)); \
    C.lds = (LAS unsigned char*)lds_raw + z_; C.tid = tid_; C.lane = tid_ & 63; C.wave = __builtin_amdgcn_readfirstlane(tid_ >> 6); C.G = gridDim.x; C.bid = blockIdx.x; \
    C.in = P.in + z_; C.out = P.out + z_; C.ws = P.ws + z_; C.ctl = (unsigned*)(P.ws + WS_CTL) + z_; } \
    unsigned char* ws = C.ws; const float* modall = (const float*)(ws + WS_MOD); float* Y = C.out + O_Y; float* X1 = (float*)(ws + WS_X1); bf16* Hb = (bf16*)(ws + WS_H); const float* modl = modall + (size_t)l * 9 * NMOD; \
    (void)Y; (void)X1; (void)Hb; (void)modl;
    volatile LAS unsigned* misc = (volatile LAS unsigned*)((LAS unsigned char*)lds_raw + LDS_MISC);
    if (threadIdx.x < 64) misc[threadIdx.x] = 0u;
    __syncthreads();
    (void)xcd_barrier_post((unsigned*)(P.ws + WS_CTL) + CW_BAR, misc);
#define GRID_BAR() do { XcdBarrier b_; { int zb_ = 0; asm volatile("" : "+s"(zb_)); b_.bar = (unsigned*)(P.ws + WS_CTL) + CW_BAR + zb_; } b_.x = xb_xcc_id(); b_.st = misc; xcd_barrier(b_); } while (0)

    { const int l = 0; { MKCTX(); for (int rep_ = 0; rep_ < REP_P0; ++rep_) p0_transposes(C); } { MKCTX(); p0_wl2(C); } { MKCTX(); for (int rep_ = 0; rep_ < REP_P0; ++rep_) p0_mod(C); } { MKCTX(); for (int rep_ = 0; rep_ < REP_P0; ++rep_) p0_filters(C); } { MKCTX(); p0_rope(C); }
      GRID_BAR();
      { MKCTX(); p0_h0(C); }
      GRID_BAR(); }

    for (int l = 0; l < DEPTH; ++l) {
        { MKCTX();
            pg8::Gemm g{Hb, (const bf16*)(ws + WS_WIN) + (size_t)l * N1 * D, M, N1, D}; pg8::StaticOrder S; S.init(M, N1, C.G, C.bid, WGM_A);
            pg8::Epi1 E{(bf16*)(ws + WS_RKVG), (bf16*)(ws + WS_QKV), (bf16*)(ws + WS_LH), (bf16*)(ws + WS_HYT), C.out + O_CK, C.out + O_CV, l, M};
            for (int rep_ = 0; rep_ < REP_GEMM; ++rep_) pg8::gemm_phase<pg8::Epi1, pg8::StaticOrder, false, true>(C.lds, g, S, E);
        }
        GRID_BAR();
        { MKCTX(); kknorm_phase(C, l); }
        { MKCTX();
            pg8::Gemm g{(const bf16*)(ws + WS_LH), (const bf16*)(ws + WS_WL2) + (size_t)l * 3072 * 256, M, 3072, 256}; pg8::StaticOrder S; S.init(M, 3072, C.G, C.bid, WGM_L);
            pg8::EpiPlain E{(bf16*)(ws + WS_LW), 3072};
            for (int rep_ = 0; rep_ < REP_GEMM; ++rep_) pg8::gemm_phase<pg8::EpiPlain, pg8::StaticOrder, false, true>(C.lds, g, S, E);
        }
        { MKCTX();
        for (;;) {
            const int it = queue_pop(C, l * 2 + 0);
            if (it >= 256 + 512 + 512 + 128) break;
            if (it < 256) {
#if !DBG_SKIP_ATTN
                for (int rep_ = 0; rep_ < REP_ATT; ++rep_) { const Ctx Ci = relaunder(C); attn_item3(Ci, l, true, it >> 5, (it >> 3) & 3, it & 7); }
#endif
            } else if (it < 768) {
#if !DBG_SKIP_HYENA
                for (int rep_ = 0; rep_ < REP_HY; ++rep_) { const Ctx Ci = relaunder(C); hyena_item<0>(Ci, l, it - 256); }
#endif
            } else if (it < 1280) {
#if !DBG_SKIP_HYENA
                for (int rep_ = 0; rep_ < REP_HY; ++rep_) { const Ctx Ci = relaunder(C); hyena_item<1>(Ci, l, it - 768); }
#endif
            } else { const int a = it - 1280;
#if !DBG_SKIP_ATTN
                for (int rep_ = 0; rep_ < REP_ATT; ++rep_) { const Ctx Ci = relaunder(C); attn_item3(Ci, l, false, a >> 2, a & 3, 0); }
#endif
            }
        } }
        GRID_BAR();
#if !DBG_SKIP_RWKV
        { MKCTX(); for (;;) { const int it = queue_pop(C, l * 2 + 1); if (it >= 960) break; for (int rep_ = 0; rep_ < REP_SCAN; ++rep_) scan2_item(C, l, it); } }
#endif
        GRID_BAR();
        { MKCTX(); for (int rep_ = 0; rep_ < REP_FIN; ++rep_) fin_phase(C, l);
#if DBG_SKIP_ATTN
        { bf16* mix = (bf16*)(ws + WS_MIX); for (int i = C.bid * 512 + C.tid; i < M * 96; i += C.G * 512) { const int row = i / 96, c8 = (i % 96) * 8; *(u32x4*)(mix + (size_t)row * D + 1280 + c8) = (u32x4){0u, 0u, 0u, 0u}; } }
#endif
        }
        GRID_BAR();
        { MKCTX();
            pg8::Gemm g{(const bf16*)(ws + WS_MIX), (const bf16*)(ws + WS_WOUT) + (size_t)l * D * D, M, D, D}; pg8::StaticOrder S; S.init(M, D, C.G, C.bid, WGM_E);
            pg8::EpiRes E{(l == 0) ? C.in[I_XP] : Y, (l == 0) ? C.in[I_XS] : Y, (l == 0) ? MC : M, modl + 2 * D, NMOD, X1, D, DN_ALPHA};
            for (int rep_ = 0; rep_ < REP_GEMM; ++rep_) pg8::gemm_phase<pg8::EpiRes, pg8::StaticOrder, true, true>(C.lds, g, S, E);
        }
        GRID_BAR();
        { MKCTX(); ln_phase(C, X1, C.in[I_LN1G] + l * D, C.in[I_LN1B] + l * D, modl, 3 * D, 4 * D, Hb); }
        GRID_BAR();
#if !DBG_SKIP_FFN
        { MKCTX();
            pg8::Gemm g{Hb, (const bf16*)(ws + WS_WUP) + (size_t)l * NUP * D, M, NUP, D}; pg8::StaticOrder S; S.init(M, NUP, C.G, C.bid, WGM_G);
            pg8::EpiGate E{(bf16*)(ws + WS_G), C.in[I_CONVW] + (size_t)l * 3 * NUP, (float*)(ws + WS_HALO), C.lds + 131072};
            for (int rep_ = 0; rep_ < REP_GEMM; ++rep_) pg8::gemm_phase<pg8::EpiGate, pg8::StaticOrder, true, true>(C.lds, g, S, E);
        }
        GRID_BAR();
        { MKCTX(); gate_fixup_phase(C, (const float*)(ws + WS_HALO), C.in[I_CONVW] + (size_t)l * 3 * NUP, (bf16*)(ws + WS_G)); }
        GRID_BAR();
#endif
        { MKCTX();
            pg8::Gemm g{(const bf16*)(ws + WS_G), (const bf16*)(ws + WS_WDN) + (size_t)l * D * DFF, M, D, DFF}; pg8::StaticOrder S; S.init(M, D, C.G, C.bid, WGM_I);
            pg8::EpiRes E{X1, X1, M, modl + 5 * D, NMOD, Y, D, DN_ALPHA};
            for (int rep_ = 0; rep_ < REP_GEMM; ++rep_) pg8::gemm_phase<pg8::EpiRes, pg8::StaticOrder, true, true>(C.lds, g, S, E);
        }
        GRID_BAR();
        { MKCTX(); ln_phase(C, Y, C.in[I_LN2G] + l * D, C.in[I_LN2B] + l * D, (l + 1 < DEPTH) ? modl + 9 * NMOD : nullptr, 0, D, Hb); }
        if (l + 1 < DEPTH) GRID_BAR();
    }
}

extern "C" void kernel_launch(void* const* d_in, const int* in_sizes, int n_in, void* d_out, int out_size, void* d_ws, size_t ws_size, hipStream_t stream) {
    static int grid = 0;
    if (grid == 0) {
        if (n_in != N_IN || ws_size < WS_END) { fprintf(stderr, "kernel_launch: unexpected n_in %d or ws_size %zu (< %zu)\n", n_in, ws_size, (size_t)WS_END); grid = -1; return; }
        int dev = 0, cus = 0, per_cu = 0;
        if (hipGetDevice(&dev) != hipSuccess || hipDeviceGetAttribute(&cus, hipDeviceAttributeMultiprocessorCount, dev) != hipSuccess) { grid = -1; return; }
        if (hipFuncSetAttribute((const void*)mega_fwd, hipFuncAttributeMaxDynamicSharedMemorySize, LDS_BYTES) != hipSuccess) { fprintf(stderr, "kernel_launch: hipFuncSetAttribute failed\n"); grid = -1; return; }
        if (hipOccupancyMaxActiveBlocksPerMultiprocessor(&per_cu, (const void*)mega_fwd, 512, LDS_BYTES) != hipSuccess || per_cu < 1) { fprintf(stderr, "kernel_launch: occupancy query says %d\n", per_cu); }
        (void)hipGetLastError();
        grid = cus;
    }
    if (grid < 0) return;
    (void)hipMemsetAsync((char*)d_ws + WS_CTL, 0, 1 * MiB, stream);
    Params p{};
    for (int i = 0; i < N_IN; ++i) p.in[i] = (const float*)d_in[i];
    p.out = (float*)d_out; p.ws = (unsigned char*)d_ws;
    hipLaunchKernelGGL(mega_fwd, dim3(grid), dim3(512), LDS_BYTES, stream, p);
}
```
